# Optimizing an MI355X kernel written in HIP

```python
import math
import jax, jax.numpy as jnp
from jax import lax
import numpy as np

D_MODEL = 1024
BATCH = 8
SEQ = 4096
DEPTH = 4

HEAD_DIM = 64
RWKV_HEADS = 8
RWKV_DIM = RWKV_HEADS * HEAD_DIM
SB_HEADS = 8
SB_DIM = SB_HEADS * HEAD_DIM
DECAY_RANK = 64
AAA_RANK = 64
GATE_RANK = 128
VRES_RANK = 32
D_FF = 2816
SB_BLOCK = 128
N_MOD = 9
RMS_EPS = 1e-6
GN_EPS = 64e-5

RWKV_COLS = 3 * RWKV_DIM + DECAY_RANK + AAA_RANK + GATE_RANK
SB_COLS = 3 * SB_DIM
GATE_COLS = 2 * D_MODEL
IN_COLS_FIRST = RWKV_COLS + SB_COLS + GATE_COLS
IN_COLS = IN_COLS_FIRST + VRES_RANK
RWKV_SPLITS = [RWKV_DIM, 2 * RWKV_DIM, 3 * RWKV_DIM, 3 * RWKV_DIM + DECAY_RANK, 3 * RWKV_DIM + DECAY_RANK + AAA_RANK]

kernel_name = "hybrid_rwkv7_stickbreaking_macaron_adaln"


def rms_norm(x, g):
    xf = x.astype(jnp.float32)
    y = xf * lax.rsqrt(jnp.mean(xf * xf, axis=-1, keepdims=True) + RMS_EPS)
    return (y * g.astype(jnp.float32)).astype(x.dtype)


def modulate(xn, shift, scale):
    return xn * (1.0 + scale[:, None, :]) + shift[:, None, :]


def swiglu(x, wg, wu, wd):
    return (jax.nn.silu(x @ wg) * (x @ wu)) @ wd


def token_shift(p):
    return jnp.pad(p[:, :-1], ((0, 0), (1, 0), (0, 0)))


def rwkv7_scan(r, w, k, v, a, b):
    bsz, _, nh, dh = r.shape
    xs = tuple(jnp.moveaxis(t, 1, 0) for t in (r, w, k, v, a, b))

    def step(state, inp):
        r_t, w_t, k_t, v_t, a_t, b_t = inp
        sa = jnp.einsum('bhvk,bhk->bhv', state, a_t)
        state = (state * w_t[:, :, None, :] + sa[..., None] * b_t[:, :, None, :]
                 + v_t[..., None] * k_t[:, :, None, :])
        y = jnp.einsum('bhvk,bhk->bhv', state, r_t)
        return state, y

    s0 = jnp.zeros((bsz, nh, dh, dh), jnp.float32)
    _, ys = lax.scan(step, s0, xs)
    return jnp.moveaxis(ys, 0, 1)


def rwkv7_branch(p, p_vres, v_first, mu, w0, w2, a0, a2, g2, k_k, k_a, r_k, lnx_w, lnx_b, v0, v2):
    bsz, slen, _ = p.shape
    f32 = jnp.float32
    p = p + (token_shift(p) - p) * mu
    r, k, v, wl, al, gl = jnp.split(p, RWKV_SPLITS, axis=-1)
    w = -jax.nn.softplus(-(w0 + jnp.tanh(wl) @ w2)) - 0.5
    decay = jnp.exp(-jnp.exp(w.astype(f32)))
    if v_first is None:
        v_first = v
    else:
        v = v + (v_first - v) * jax.nn.sigmoid(v0 + p_vres @ v2)
    a = jax.nn.sigmoid(a0 + al @ a2)
    g = jax.nn.sigmoid(gl) @ g2

    def heads(t):
        return t.astype(f32).reshape(bsz, slen, RWKV_HEADS, HEAD_DIM)

    kk = heads(k * k_k)
    kk = kk / jnp.maximum(jnp.sqrt(jnp.sum(kk * kk, axis=-1, keepdims=True)), 1e-12)
    k = k * (1.0 + (a - 1.0) * k_a)
    rh, kh, vh = heads(r), heads(k), heads(v)
    y = rwkv7_scan(rh, heads(decay), kh, vh, -kk, kk * heads(a))
    mean = jnp.mean(y, axis=-1, keepdims=True)
    var = jnp.mean(jnp.square(y - mean), axis=-1, keepdims=True)
    y = ((y - mean) * lax.rsqrt(var + GN_EPS)).reshape(bsz, slen, RWKV_DIM)
    y = y * lnx_w.astype(f32) + lnx_b.astype(f32)
    bonus = jnp.sum(rh * kh * r_k.astype(f32), axis=-1, keepdims=True) * vh
    y = (y + bonus.reshape(bsz, slen, RWKV_DIM)) * g.astype(f32)
    return y.astype(p.dtype), v_first


def stick_breaking_attention(q, k, v):
    bsz, nh, slen, dh = q.shape
    f32 = jnp.float32
    q, k, v = q.astype(f32), k.astype(f32), v.astype(f32)
    n_blk = slen // SB_BLOCK
    inv_sqrt_d = 1.0 / math.sqrt(dh)
    offs = jnp.arange(SB_BLOCK)

    def q_block(qi):
        q0 = qi * SB_BLOCK
        qb = lax.dynamic_slice_in_dim(q, q0, SB_BLOCK, axis=2) * inv_sqrt_d
        qpos = q0 + offs

        def body(i, carry):
            acc, logsurv = carry
            k0 = (qi - i) * SB_BLOCK
            kb = lax.dynamic_slice_in_dim(k, k0, SB_BLOCK, axis=2)
            vb = lax.dynamic_slice_in_dim(v, k0, SB_BLOCK, axis=2)
            kpos = k0 + offs
            z = jnp.einsum('bhqd,bhkd->bhqk', qb, kb)
            mask = kpos[None, :] < qpos[:, None]
            log_fail = jnp.where(mask, -jax.nn.softplus(z), 0.0)
            csum = jnp.cumsum(log_fail, axis=-1)
            row = csum[..., -1:]
            log_a = jax.nn.log_sigmoid(z) + logsurv[..., None] + (row - csum)
            weight = jnp.where(mask, jnp.exp(log_a), 0.0)
            acc = acc + jnp.einsum('bhqk,bhkd->bhqd', weight, vb)
            return acc, logsurv + row[..., 0]

        acc0 = jnp.zeros((bsz, nh, SB_BLOCK, dh), f32)
        ls0 = jnp.zeros((bsz, nh, SB_BLOCK), f32)
        acc, _ = lax.fori_loop(0, qi + 1, body, (acc0, ls0))
        return acc

    out = lax.map(q_block, jnp.arange(n_blk))
    return out.transpose(1, 0, 3, 2, 4).reshape(bsz, slen, nh * dh)


def setup_inputs(seed: int = 0) -> dict:
    key = jax.random.key(seed)
    ks = iter(jax.random.split(key, 40))
    f32 = jnp.float32

    def nrm(shape, scale):
        return jax.random.normal(next(ks), shape, f32) * scale

    def gain(shape):
        return 1.0 + nrm(shape, 0.02)

    L = DEPTH
    d = D_MODEL
    return {
        "x": nrm((BATCH, SEQ, d), 1.0),
        "c": nrm((BATCH, d), 1.0),
        "mod_w": nrm((L, d, N_MOD * d), d ** -0.5),
        "mod_b": nrm((L, N_MOD * d), 0.01),
        "norm_g": gain((L, 3, d)),
        "ffn1_wg": nrm((L, d, D_FF), d ** -0.5),
        "ffn1_wu": nrm((L, d, D_FF), d ** -0.5),
        "ffn1_wd": nrm((L, D_FF, d), D_FF ** -0.5),
        "w_in_first": nrm((d, IN_COLS_FIRST), d ** -0.5),
        "w_in_rest": nrm((L - 1, d, IN_COLS), d ** -0.5),
        "shift_mu": jax.random.uniform(next(ks), (L, RWKV_COLS), f32),
        "decay_w0": jax.random.uniform(next(ks), (L, RWKV_DIM), f32, -6.0, -1.0),
        "decay_w2": nrm((L, DECAY_RANK, RWKV_DIM), 0.5 * DECAY_RANK ** -0.5),
        "aaa_a0": nrm((L, RWKV_DIM), 0.1),
        "aaa_a2": nrm((L, AAA_RANK, RWKV_DIM), AAA_RANK ** -0.5),
        "gate_g2": nrm((L, GATE_RANK, RWKV_DIM), GATE_RANK ** -0.5),
        "k_k": 0.85 + nrm((L, RWKV_DIM), 0.05),
        "k_a": 1.0 + nrm((L, RWKV_DIM), 0.05),
        "r_k": nrm((L, RWKV_HEADS, HEAD_DIM), 0.1),
        "lnx_w": 1.0 + nrm((L, RWKV_DIM), 0.05),
        "lnx_b": nrm((L, RWKV_DIM), 0.01),
        "vres_v0": 0.5 + nrm((L - 1, RWKV_DIM), 0.1),
        "vres_v2": nrm((L - 1, VRES_RANK, RWKV_DIM), VRES_RANK ** -0.5),
        "q_norm_g": gain((L, HEAD_DIM)),
        "k_norm_g": gain((L, HEAD_DIM)),
        "w_up_a": nrm((L, RWKV_DIM, d), RWKV_DIM ** -0.5),
        "w_up_b": nrm((L, SB_DIM, d), SB_DIM ** -0.5),
        "w_out": nrm((L, d, d), d ** -0.5),
        "ffn2_wg": nrm((L, d, D_FF), d ** -0.5),
        "ffn2_wu": nrm((L, d, D_FF), d ** -0.5),
        "ffn2_wd": nrm((L, D_FF, d), D_FF ** -0.5),
    }


def reference(x, c, mod_w, mod_b, norm_g, ffn1_wg, ffn1_wu, ffn1_wd, w_in_first, w_in_rest,
              shift_mu, decay_w0, decay_w2, aaa_a0, aaa_a2, gate_g2, k_k, k_a, r_k, lnx_w, lnx_b,
              vres_v0, vres_v2, q_norm_g, k_norm_g, w_up_a, w_up_b, w_out,
              ffn2_wg, ffn2_wu, ffn2_wd):
    bsz, slen, _ = x.shape
    h = x
    c_act = jax.nn.silu(c)
    v_first = None
    o_sb = RWKV_COLS
    o_gate = RWKV_COLS + SB_COLS
    for l in range(DEPTH):
        mod = (c_act @ mod_w[l] + mod_b[l]).reshape(bsz, N_MOD, D_MODEL)
        sh1, sc1, gt1, sh2, sc2, gt2, sh3, sc3, gt3 = [mod[:, i] for i in range(N_MOD)]

        n1 = modulate(rms_norm(h, norm_g[l, 0]), sh1, sc1)
        h = h + 0.5 * gt1[:, None, :] * swiglu(n1, ffn1_wg[l], ffn1_wu[l], ffn1_wd[l])

        n2 = modulate(rms_norm(h, norm_g[l, 1]), sh2, sc2)
        if l == 0:
            proj = n2 @ w_in_first
            p_vres, v0, v2 = None, None, None
        else:
            proj = n2 @ w_in_rest[l - 1]
            p_vres, v0, v2 = proj[..., IN_COLS_FIRST:], vres_v0[l - 1], vres_v2[l - 1]

        y_a, v_first = rwkv7_branch(proj[..., :RWKV_COLS], p_vres, v_first, shift_mu[l],
                                    decay_w0[l], decay_w2[l], aaa_a0[l], aaa_a2[l], gate_g2[l],
                                    k_k[l], k_a[l], r_k[l], lnx_w[l], lnx_b[l], v0, v2)

        p_sb = proj[..., o_sb:o_gate].reshape(bsz, slen, 3, SB_HEADS, HEAD_DIM)
        q = rms_norm(p_sb[:, :, 0], q_norm_g[l]).transpose(0, 2, 1, 3)
        k = rms_norm(p_sb[:, :, 1], k_norm_g[l]).transpose(0, 2, 1, 3)
        v = p_sb[:, :, 2].transpose(0, 2, 1, 3)
        y_b = stick_breaking_attention(q, k, v).astype(h.dtype)

        gate_a = jax.nn.sigmoid(proj[..., o_gate:o_gate + D_MODEL])
        gate_b = jax.nn.sigmoid(proj[..., o_gate + D_MODEL:o_gate + 2 * D_MODEL])
        merged = gate_a * (y_a @ w_up_a[l]) + gate_b * (y_b @ w_up_b[l])
        h = h + gt2[:, None, :] * (merged @ w_out[l])

        n3 = modulate(rms_norm(h, norm_g[l, 2]), sh3, sc3)
        h = h + 0.5 * gt3[:, None, :] * swiglu(n3, ffn2_wg[l], ffn2_wu[l], ffn2_wd[l])
    return h
```

```cpp
#include <hip/hip_runtime.h>
#include <hip/hip_cooperative_groups.h>
#include <cstdio>
#include <cstdint>
namespace cg = cooperative_groups;
namespace pg8 {
#define PG8_LAS __attribute__((address_space(3)))
typedef unsigned short bf16_t;
typedef _Float16 pg8_h8 __attribute__((ext_vector_type(8)));
typedef short bf16x8 __attribute__((ext_vector_type(8)));
typedef float f32x4 __attribute__((ext_vector_type(4)));
typedef unsigned u32x4 __attribute__((ext_vector_type(4)));
constexpr int BM = 256, BK = 64, HALF = 128, HTB = HALF * BK * 2  , STAGE_BYTES = 8 * HTB, NXCD = 8, WGM = 8;

__host__ __device__ __forceinline__ int lds_byte(int r, int c) { const int st = (r >> 4) * 2 + (c >> 5), rr = r & 15, cc = c & 31, ob = rr * 64 + cc * 2; return st * 1024 + (ob ^ (((ob >> 9) & 1) << 5)); }
__host__ __device__ __forceinline__ void stage_rc(int b, int& R, int& C) { const int st = b / 1024, sb = b % 1024, swz = sb ^ (((sb >> 9) & 1) << 5); R = (st >> 1) * 16 + swz / 64; C = (st & 1) * 32 + (swz % 64) / 2; }
__host__ __device__ __forceinline__ int perm32(int rho) { const int n = rho >> 4, i = rho & 15; return 8 * (i >> 2) + 4 * n + (i & 3); }

struct Unit { int pm, pn; };
struct Gemm { const bf16_t* A; const bf16_t* Bt; int M, N, K; };

struct StaticOrder {
    int nM, nN, nwg, G, c, wgm;
    __host__ __device__ void init(int M, int N, int G_, int c_, int wgm_ = 4) { nM = M / BM; nN = N / BM; nwg = nM * nN; G = G_; c = c_; wgm = wgm_; }
    __host__ __device__ bool next(int i, Unit& u) const {
        const long L = (long)i * G + c; if (L >= nwg) return false;
        int wgid = (int)L; { const int q = nwg / NXCD, r = nwg % NXCD, xcd = wgid % NXCD, off = wgid / NXCD; wgid = (xcd < r ? xcd * (q + 1) : r * (q + 1) + (xcd - r) * q) + off; }
        const int nig = wgm * nN, gid = wgid / nig, fm = gid * wgm, gsz = (nM - fm) < wgm ? (nM - fm) : wgm;
        u.pm = fm + ((wgid % nig) % gsz); u.pn = (wgid % nig) / gsz; return true;
    }
    __device__ __forceinline__ void a_ready(const Unit&) const {}
    __device__ __forceinline__ void done(const Unit&) const {}
};

__device__ __forceinline__ unsigned cvt_pk_bf16(float lo, float hi) { unsigned r; asm volatile("v_cvt_pk_bf16_f32 %0, %1, %2" : "=v"(r) : "v"(lo), "v"(hi)); return r; }
template <class Epi, class Sched, bool ALIGN_EPI = false, bool SP2 = false>
__device__ __forceinline__ void gemm_phase(PG8_LAS unsigned char* lds, const Gemm g, const Sched& S, const Epi& E, const int wave_s) {
    int lane_; asm volatile("v_mbcnt_lo_u32_b32 %0, -1, 0\n\tv_mbcnt_hi_u32_b32 %0, -1, %0" : "=v"(lane_));
    const int wid = wave_s, lane = lane_, tid = wid * 64 + lane, wr = wid >> 2, wc = wid & 3, fr = lane & 15, fq = lane >> 4;
    const int K = g.K, nt = K / BK;
    unsigned voffA[2], voffB[2];
#pragma unroll
    for (int i = 0; i < 2; ++i) { int R, C; stage_rc(tid * 16 + i * 8192, R, C); const int Rb = Epi::PERM ? ((R & ~31) + perm32(R & 31)) : R;
        voffA[i] = (unsigned)(R * K + C) * 2u; voffB[i] = (unsigned)(Rb * K + C) * 2u; }
    const size_t kstep = (size_t)(BK * 2);
    const size_t hstep = (size_t)HALF * K * 2;
    const size_t tstep = 2 * hstep;
    const unsigned ldsw = (unsigned)wid * 1024u;
    const int aoff = lds_byte(wr * 64 + fr, fq * 8), boff = lds_byte(wc * 32 + fr, fq * 8);
#define PG8_SA(b, h) (((b) * 2 + (h)) * HTB)
#define PG8_SB(b, h) ((4 + (b) * 2 + (h)) * HTB)
#define PG8_STAGE(bufoff, gbase, voff) do { _Pragma("unroll") for (int _i = 0; _i < 2; ++_i) \
        __builtin_amdgcn_global_load_lds((const unsigned*)((const char*)(gbase) + (voff)[_i]), (PG8_LAS unsigned*)(lds + (bufoff) + ldsw + _i * 8192), 16, 0, 0); } while (0)
#define PG8_LDA(dst, b, h) do { _Pragma("unroll") for (int m = 0; m < 4; ++m) _Pragma("unroll") for (int k = 0; k < 2; ++k) dst[m][k] = *(const PG8_LAS bf16x8*)(lds + PG8_SA(b, h) + aoff + m * 2048 + k * 1024); } while (0)
#define PG8_LDB(dst, b, h) do { _Pragma("unroll") for (int n = 0; n < 2; ++n) _Pragma("unroll") for (int k = 0; k < 2; ++k) dst[n][k] = *(const PG8_LAS bf16x8*)(lds + PG8_SB(b, h) + boff + n * 2048 + k * 1024); } while (0)
#define PG8_MMA(ai, bj, At, Bt) do { __builtin_amdgcn_s_setprio(1); _Pragma("unroll") for (int m = 0; m < 4; ++m) _Pragma("unroll") for (int n = 0; n < 2; ++n) _Pragma("unroll") for (int k = 0; k < 2; ++k) \
        acc[ai][bj][m][n] = __builtin_amdgcn_mfma_f32_16x16x32_f16(__builtin_bit_cast(pg8_h8, Bt[n][k]), __builtin_bit_cast(pg8_h8, At[m][k]), acc[ai][bj][m][n], 0, 0, 0); __builtin_amdgcn_s_setprio(0); } while (0)
#define PG8_WAIT_V(n) asm volatile("s_waitcnt vmcnt(" #n ")" ::: "memory")
#define PG8_WAIT_L(n) asm volatile("s_waitcnt lgkmcnt(" #n ")" ::: "memory")
#define PG8_BAR __builtin_amdgcn_s_barrier()
#define PG8_SCHED __builtin_amdgcn_sched_barrier(0)
    Unit cur, nxt; int ui = 0;
    if (!S.next(0, cur)) return;
    f32x4 acc[2][2][4][2];
#pragma unroll
    for (int a = 0; a < 2; ++a)
#pragma unroll
        for (int b = 0; b < 2; ++b)
#pragma unroll
            for (int m = 0; m < 4; ++m)
#pragma unroll
                for (int n = 0; n < 2; ++n) acc[a][b][m][n] = (f32x4){0.f, 0.f, 0.f, 0.f};
    bf16x8 At[4][2], B0[2][2], B1[2][2];
    const char* cA = (const char*)g.A + (size_t)cur.pm * tstep; const char* cB = (const char*)g.Bt + (size_t)cur.pn * tstep;
    S.a_ready(cur);
    if constexpr (SP2) {
        PG8_STAGE(PG8_SB(0, 0), cB, voffB); PG8_STAGE(PG8_SB(0, 1), cB + hstep, voffB); PG8_STAGE(PG8_SA(0, 0), cA, voffA); PG8_STAGE(PG8_SA(0, 1), cA + hstep, voffA);
        if (wr == 1) PG8_BAR;
        PG8_WAIT_V(2); PG8_BAR;
        PG8_STAGE(PG8_SB(1, 0), cB + kstep, voffB); PG8_STAGE(PG8_SA(1, 0), cA + kstep, voffA); PG8_STAGE(PG8_SB(1, 1), cB + hstep + kstep, voffB);
        PG8_WAIT_V(6); PG8_BAR;
    } else {
        PG8_STAGE(PG8_SB(0, 0), cB, voffB); PG8_STAGE(PG8_SA(0, 0), cA, voffA); PG8_STAGE(PG8_SB(0, 1), cB + hstep, voffB); PG8_STAGE(PG8_SA(0, 1), cA + hstep, voffA);
        if (wr == 1) PG8_BAR;
        PG8_WAIT_V(4); PG8_BAR;
        PG8_STAGE(PG8_SB(1, 0), cB + kstep, voffB); PG8_STAGE(PG8_SA(1, 0), cA + kstep, voffA); PG8_STAGE(PG8_SB(1, 1), cB + hstep + kstep, voffB);
        PG8_WAIT_V(6); PG8_BAR;
    }
    for (;;) {
        const bool has_next = S.next(ui + 1, nxt);
        const char* nA = has_next ? (const char*)g.A + (size_t)nxt.pm * tstep : cA; const char* nB = has_next ? (const char*)g.Bt + (size_t)nxt.pn * tstep : cB;
        for (int t = 0; t < nt; t += 2) {
            const bool last = (t == nt - 2);
            const char* a1 = cA + (size_t)(t + 1) * kstep;
            const char* a2 = last ? nA : cA + (size_t)(t + 2) * kstep; const char* b2 = last ? nB : cB + (size_t)(t + 2) * kstep;
            const char* a3 = a2 + kstep; const char* b3 = b2 + kstep;
            if (last && has_next) S.a_ready(nxt);
            if constexpr (SP2) {
            PG8_LDB(B0, 0, 0); PG8_LDB(B1, 0, 1); PG8_SCHED; PG8_LDA(At, 0, 0); PG8_STAGE(PG8_SA(1, 1), a1 + hstep, voffA);
            PG8_WAIT_V(8); PG8_WAIT_L(0); PG8_BAR; PG8_MMA(0, 0, At, B0); PG8_MMA(0, 1, At, B1); PG8_BAR; PG8_SCHED;
            PG8_LDA(At, 0, 1); PG8_STAGE(PG8_SB(0, 0), b2, voffB); PG8_STAGE(PG8_SB(0, 1), b2 + hstep, voffB); PG8_STAGE(PG8_SA(0, 0), a2, voffA);
            PG8_WAIT_V(8); PG8_WAIT_L(0); PG8_BAR; PG8_MMA(1, 0, At, B0); PG8_MMA(1, 1, At, B1); PG8_BAR; PG8_SCHED;
            PG8_LDB(B0, 1, 0); PG8_LDB(B1, 1, 1); PG8_SCHED; PG8_LDA(At, 1, 0); PG8_STAGE(PG8_SA(0, 1), a2 + hstep, voffA);
            PG8_WAIT_V(8); PG8_WAIT_L(0); PG8_BAR; PG8_MMA(0, 0, At, B0); PG8_MMA(0, 1, At, B1); PG8_BAR; PG8_SCHED;
            PG8_LDA(At, 1, 1); PG8_STAGE(PG8_SB(1, 0), b3, voffB); PG8_STAGE(PG8_SB(1, 1), b3 + hstep, voffB); PG8_STAGE(PG8_SA(1, 0), a3, voffA);
            PG8_WAIT_V(8); PG8_WAIT_L(0); PG8_BAR; PG8_MMA(1, 0, At, B0); PG8_MMA(1, 1, At, B1); PG8_BAR; PG8_SCHED;
            } else {
            PG8_LDB(B0, 0, 0); PG8_SCHED; PG8_LDA(At, 0, 0); PG8_STAGE(PG8_SA(1, 1), a1 + hstep, voffA);
            PG8_WAIT_L(8); PG8_BAR; PG8_WAIT_L(0); PG8_MMA(0, 0, At, B0); PG8_BAR; PG8_SCHED;
            PG8_LDB(B1, 0, 1); PG8_STAGE(PG8_SB(0, 0), b2, voffB);
            PG8_BAR; PG8_WAIT_L(0); PG8_MMA(0, 1, At, B1); PG8_BAR;
            PG8_LDA(At, 0, 1); PG8_STAGE(PG8_SA(0, 0), a2, voffA);
            PG8_BAR; PG8_WAIT_L(0); PG8_MMA(1, 0, At, B0); PG8_BAR; PG8_SCHED;
            PG8_STAGE(PG8_SB(0, 1), b2 + hstep, voffB);
            PG8_WAIT_V(6); PG8_BAR; PG8_MMA(1, 1, At, B1); PG8_BAR;
            PG8_LDB(B0, 1, 0); PG8_SCHED; PG8_LDA(At, 1, 0); PG8_STAGE(PG8_SA(0, 1), a2 + hstep, voffA);
            PG8_WAIT_L(8); PG8_BAR; PG8_WAIT_L(0); PG8_MMA(0, 0, At, B0); PG8_BAR; PG8_SCHED;
            PG8_LDB(B1, 1, 1); PG8_STAGE(PG8_SB(1, 0), b3, voffB);
            PG8_BAR; PG8_WAIT_L(0); PG8_MMA(0, 1, At, B1); PG8_BAR;
            PG8_LDA(At, 1, 1); PG8_STAGE(PG8_SA(1, 0), a3, voffA);
            PG8_BAR; PG8_WAIT_L(0); PG8_MMA(1, 0, At, B0); PG8_BAR; PG8_SCHED;
            PG8_STAGE(PG8_SB(1, 1), b3 + hstep, voffB);
            PG8_WAIT_V(6); PG8_BAR; PG8_MMA(1, 1, At, B1); PG8_BAR;
            }
        }
        if constexpr (ALIGN_EPI) { if (wr == 0) PG8_BAR; }
        if constexpr (!Epi::AFTER_DRAIN) { E(acc, cur, wr, wc, fr, fq); S.done(cur); }
        if (!has_next) break;
#pragma unroll
        for (int a = 0; a < 2; ++a)
#pragma unroll
            for (int b = 0; b < 2; ++b)
#pragma unroll
                for (int m = 0; m < 4; ++m)
#pragma unroll
                    for (int n = 0; n < 2; ++n) acc[a][b][m][n] = (f32x4){0.f, 0.f, 0.f, 0.f};
        cur = nxt; cA = nA; cB = nB; ++ui;
        if constexpr (ALIGN_EPI) { if (wr == 1) PG8_BAR; }
    }
    PG8_WAIT_V(0);
    if constexpr (!ALIGN_EPI) { if (wr == 0) PG8_BAR; }
    PG8_BAR;
    if constexpr (Epi::AFTER_DRAIN) { E.fused(acc, cur, wr, wc, fr, fq, lds, wid, lane); S.done(cur); }
#undef PG8_SA
#undef PG8_SB
#undef PG8_STAGE
#undef PG8_LDA
#undef PG8_LDB
#undef PG8_MMA
#undef PG8_WAIT_V
#undef PG8_WAIT_L
#undef PG8_BAR
#undef PG8_SCHED
}
}
#define LAS __attribute__((address_space(3)))
typedef unsigned short bf16;
typedef unsigned v4u __attribute__((ext_vector_type(4)));
typedef unsigned v2u __attribute__((ext_vector_type(2)));
typedef float f32x4 __attribute__((ext_vector_type(4)));
typedef float f32x2 __attribute__((ext_vector_type(2)));
typedef float f32x16 __attribute__((ext_vector_type(16)));
typedef short bf16x8 __attribute__((ext_vector_type(8)));

constexpr int NB = 8, S = 4096, M = NB * S, D = 1024, FF = 2816, NH = 8, HD = 64, RW = 512;
constexpr int PRW_LD = 1824, NPH_LAYER = 14, NPHASES = 1 + 4 * NPH_LAYER;
constexpr float LOG2E = 1.4426950408889634f, LN2 = 0.6931471805599453f;
constexpr size_t MiB = 1u << 20, HM = MiB / 2;
constexpr size_t WS_CTL = 0, WS_MOD = 1 * MiB;
constexpr size_t WS_WG1 = 3 * MiB, WS_WG2 = 14 * MiB, WS_WIN = 19 * MiB + HM, WS_WUPA = 30 * MiB + HM, WS_WUPB = 31 * MiB + HM, WS_WOUT = 32 * MiB + HM,
                 WS_WG1B = 34 * MiB + HM, WS_WG2B = 45 * MiB + HM, WS_WLORA = 51 * MiB;
constexpr size_t WS_PRW = 53 * MiB, WS_Q = 167 * MiB, WS_K = 199 * MiB, WS_VT = 231 * MiB, WS_H16 = 263 * MiB, WS_ACT = 53 * MiB;
constexpr size_t WS_WL2 = 53 * MiB, WS_BB = 85 * MiB, WS_GG = 117 * MiB, WS_MERGED = 53 * MiB;
constexpr size_t WS_R = 391 * MiB, WS_KM = 423 * MiB, WS_KK = 455 * MiB, WS_VV = 487 * MiB, WS_N = 391 * MiB, WS_TEMP = 391 * MiB;
constexpr size_t WS_YA = 519 * MiB, WS_YB = 551 * MiB, WS_ALORA = 519 * MiB, WS_VFIRST = 583 * MiB, WS_END = 615 * MiB;
constexpr int LDS_BYTES = 147456, MISC_OFF = 131072;

typedef _Float16 h16x2 __attribute__((ext_vector_type(2)));
typedef _Float16 h16x8 __attribute__((ext_vector_type(8)));
__device__ __forceinline__ unsigned f2bf(float f) { return (unsigned)__builtin_bit_cast(unsigned short, (_Float16)f); }
__device__ __forceinline__ unsigned pk2(float lo, float hi) { const h16x2 v = {(_Float16)lo, (_Float16)hi}; return __builtin_bit_cast(unsigned, v); }
__device__ __forceinline__ float bflo(unsigned u) { const h16x2 v = __builtin_bit_cast(h16x2, u); return (float)v.x; }
__device__ __forceinline__ float bfhi(unsigned u) { const h16x2 v = __builtin_bit_cast(h16x2, u); return (float)v.y; }
__device__ __forceinline__ float fexp(float x) { return __builtin_amdgcn_exp2f(x * LOG2E); }
__device__ __forceinline__ float flog(float x) { return __builtin_amdgcn_logf(x) * LN2; }
__device__ __forceinline__ float sigmoidf_(float x) { return __builtin_amdgcn_rcpf(1.f + fexp(-x)); }
#define SHX(v, o) __uint_as_float(__builtin_amdgcn_ds_bpermute(((lane) ^ (o)) << 2, __float_as_uint(v)))
__device__ __forceinline__ float wave_sum(float v, int lane) {
#pragma unroll
    for (int o = 1; o < 64; o <<= 1) v += SHX(v, o);
    return v;
}
template <int CTRL> __device__ __forceinline__ float dppf(float x) { return __uint_as_float(__builtin_amdgcn_update_dpp(0u, __float_as_uint(x), CTRL, 0xf, 0xf, false)); }
__device__ __forceinline__ float red16(float x) { x += dppf<0x128>(x); x += dppf<0x124>(x); x += dppf<0x122>(x); x += dppf<0x121>(x); return x; }
#define LDS_WAIT() asm volatile("s_waitcnt lgkmcnt(0)" ::: "memory")

struct Args { const float* in[31]; float* out; unsigned char* ws; int ph_lo, ph_hi; };
typedef const __attribute__((address_space(4))) Args* CArgs;
#define EPI_FENCE() asm volatile("" ::: "memory")

__device__ __forceinline__ int fresh_lane() { int ln; asm volatile("v_mbcnt_lo_u32_b32 %0, -1, 0\n\tv_mbcnt_hi_u32_b32 %0, -1, %0" : "=v"(ln)); return ln; }
#define EPI_IDX() const int t_ = fresh_lane(); const int fr = t_ & 15, fq = t_ >> 4
__device__ __forceinline__ v4u pack8(const f32x4 a, const f32x4 b);
struct EpiSwiglu {
    static constexpr bool PERM = true, AFTER_DRAIN = false;
    bf16* act;
    __device__ __forceinline__ void operator()(const f32x4 (&acc)[2][2][4][2], const pg8::Unit& u, int wr, int wc, int, int) const {
        EPI_IDX();
        const int row0 = u.pm * 256 + wr * 64 + fr, f0 = u.pn * 128 + wc * 32 + fq * 8;
#pragma unroll
        for (int ai = 0; ai < 2; ++ai)
#pragma unroll
            for (int m = 0; m < 4; ++m) { bf16* rp = act + (size_t)(row0 + ai * 128 + m * 16) * FF + f0; f32x4 o[2];
#pragma unroll
                for (int n = 0; n < 2; ++n) { const f32x4 g = acc[ai][0][m][n], uu = acc[ai][1][m][n];
#pragma unroll
                    for (int j = 0; j < 4; ++j) o[n][j] = g[j] * uu[j] * __builtin_amdgcn_rcpf(1.f + __builtin_amdgcn_exp2f(-g[j] * LOG2E)); }
                __builtin_nontemporal_store(pack8(o[0], o[1]), (v4u*)rp);
                EPI_FENCE(); }
    }
};
struct EpiResid {
    static constexpr bool PERM = true, AFTER_DRAIN = false;
    CArgs a; int l, idx;
    __device__ __forceinline__ void operator()(const f32x4 (&acc)[2][2][4][2], const pg8::Unit& u, int wr, int wc, int, int) const {
        EPI_IDX();
        unsigned char* ws = a->ws; const float* mod = (const float*)(ws + WS_MOD);
        const bool in32 = (l == 0 && idx == 2), out32 = (l == 3 && idx == 13);
        const float* x32 = a->in[0]; float* o32 = a->out; bf16* h16 = (bf16*)(ws + WS_H16);
        const float* gt = mod + (size_t)l * 8 * 9216 + (idx == 2 ? 2 : (idx == 10 ? 5 : 8)) * 1024; const float fac = idx == 10 ? 1.f : 0.5f;
        const int row0 = u.pm * 256 + wr * 64 + fr, col0 = u.pn * 256 + wc * 32 + 8 * fq, b = u.pm >> 4;
#pragma unroll
        for (int bj = 0; bj < 2; ++bj) { const int col = col0 + bj * 128; const f32x4 g0 = *(const f32x4*)(gt + b * 9216 + col) * fac, g1 = *(const f32x4*)(gt + b * 9216 + col + 4) * fac;
#pragma unroll
            for (int ai = 0; ai < 2; ++ai)
#pragma unroll
                for (int m = 0; m < 4; ++m) { const size_t off = (size_t)(row0 + ai * 128 + m * 16) * D + col; f32x4 h0, h1;
                    if (in32) { h0 = *(const f32x4*)(x32 + off); h1 = *(const f32x4*)(x32 + off + 4); }
                    else { const v4u q = *(const v4u*)(h16 + off); h0 = (f32x4){bflo(q.x), bfhi(q.x), bflo(q.y), bfhi(q.y)}; h1 = (f32x4){bflo(q.z), bfhi(q.z), bflo(q.w), bfhi(q.w)}; }
                    const f32x4 o0 = h0 + g0 * acc[ai][bj][m][0], o1 = h1 + g1 * acc[ai][bj][m][1];
                    if (out32) { *(f32x4*)(o32 + off) = o0; *(f32x4*)(o32 + off + 4) = o1; }
                    else { v4u w; w.x = pk2(o0[0], o0[1]); w.y = pk2(o0[2], o0[3]); w.z = pk2(o1[0], o1[1]); w.w = pk2(o1[2], o1[3]); *(v4u*)(h16 + off) = w; }
                    if (m & 1) EPI_FENCE(); } }
    }
};
__device__ __forceinline__ v4u pack8(const f32x4 a, const f32x4 b) { v4u w; w.x = pk2(a[0], a[1]); w.y = pk2(a[2], a[3]); w.z = pk2(b[0], b[1]); w.w = pk2(b[2], b[3]); return w; }
struct EpiIn {
    static constexpr bool PERM = true, AFTER_DRAIN = false;
    unsigned char* ws; float* gates_base;
    __device__ __forceinline__ void operator()(const f32x4 (&acc)[2][2][4][2], const pg8::Unit& u, int wr, int wc, int, int) const {
        EPI_IDX();
        const int row0 = u.pm * 256 + wr * 64 + fr, pn = u.pn;
        bf16 *prw = (bf16*)(ws + WS_PRW), *q = (bf16*)(ws + WS_Q), *k = (bf16*)(ws + WS_K), *vt = (bf16*)(ws + WS_VT), *gates = (bf16*)gates_base;
#pragma unroll
        for (int ai = 0; ai < 2; ++ai)
#pragma unroll
            for (int m = 0; m < 4; ++m) { const int row = row0 + ai * 128 + m * 16;
#pragma unroll
                for (int bj = 0; bj < 2; ++bj) { const int col = pn * 256 + bj * 128 + wc * 32 + 8 * fq; const f32x4 v0 = acc[ai][bj][m][0], v1 = acc[ai][bj][m][1];
                    if (pn < 7) { __builtin_nontemporal_store(pack8(v0, v1), (v4u*)(prw + (size_t)row * PRW_LD + col)); }
                    else if (pn < 13) { const int c2 = col - 1792, which = c2 >> 9, hd = c2 & 511, hh = hd >> 6, d = hd & 63, b = row >> 12, s = row & 4095;
                        if (which < 2) { bf16* dst = (which ? k : q) + ((size_t)((b * NH + hh) * S + s)) * HD + d; *(v4u*)dst = pack8(v0, v1); }
                        else { bf16* dst = vt + ((size_t)((b * NH + hh) * HD + d)) * S + s;
#pragma unroll
                            for (int e = 0; e < 4; ++e) { dst[(size_t)e * S] = (bf16)f2bf(v0[e]); dst[(size_t)(e + 4) * S] = (bf16)f2bf(v1[e]); } } }
                    else if (pn < 21) { __builtin_nontemporal_store(pack8(v0, v1), (v4u*)(gates + (size_t)row * 2048 + (col - 3328))); }
                    else { if (col < 5408) *(v4u*)(prw + (size_t)row * PRW_LD + 1792 + (col - 5376)) = pack8(v0, v1); } }
                EPI_FENCE(); }
    }
};
__device__ __forceinline__ f32x4 unpack4(const v2u q) { return (f32x4){bflo(q.x), bfhi(q.x), bflo(q.y), bfhi(q.y)}; }
__device__ __forceinline__ v2u pack4(const f32x4 a) { v2u w; w.x = pk2(a[0], a[1]); w.y = pk2(a[2], a[3]); return w; }
template <int GRPT> struct EpiLora {
    static constexpr bool PERM = true, AFTER_DRAIN = false;
    CArgs a; int l;
    template <int GRP> __device__ __forceinline__ void run(const f32x4 (&acc)[2][2][4][2], const pg8::Unit& u, int wr, int wc, int, int) const {
        EPI_IDX();
        const int row0 = u.pm * 256 + wr * 64 + fr;
        unsigned char* ws = a->ws;
        bf16 *km = (bf16*)(ws + WS_KM), *kk = (bf16*)(ws + WS_KK), *vv = (bf16*)(ws + WS_VV), *wl2 = (bf16*)(ws + WS_WL2), *bb = (bf16*)(ws + WS_BB), *gg = (bf16*)(ws + WS_GG); const bf16* vfirst = (const bf16*)(ws + WS_VFIRST);
        const float* pv = GRP == 0 ? a->in[11] + l * 512 : (GRP == 1 ? a->in[13] + l * 512 : a->in[21] + (l > 0 ? (l - 1) * 512 : 0));
        const float* ka = a->in[17] + l * 512;
#pragma unroll
        for (int bj = 0; bj < 2; ++bj)
#pragma unroll
            for (int n = 0; n < 2; ++n) { const int ch = (u.pn & 1) * 256 + bj * 128 + wc * 32 + 8 * fq + 4 * n;
                f32x4 c0 = (f32x4){0.f, 0.f, 0.f, 0.f}, ka0 = c0;
                if (GRP != 2) c0 = *(const f32x4*)(pv + ch);
                if (GRP == 1) ka0 = *(const f32x4*)(ka + ch);
#pragma unroll
                for (int ai = 0; ai < 2; ++ai)
#pragma unroll
                    for (int m = 0; m < 4; ++m) { const size_t off = (size_t)(row0 + ai * 128 + m * 16) * RW + ch; f32x4 x0 = acc[ai][bj][m][n] + c0;
                        if (GRP == 0) {
#pragma unroll
                            for (int e = 0; e < 4; ++e) { const float p = -x0[e]; const float sp = fmaxf(p, 0.f) + flog(1.f + fexp(-fabsf(p))); x0[e] = -fexp(-sp - 0.5f) * LOG2E; }
                            *(v2u*)(wl2 + off) = pack4(x0);
                        } else if (GRP == 1) { f32x4 k0 = unpack4(*(const v2u*)(km + off)), n0 = unpack4(*(const v2u*)(kk + off));
#pragma unroll
                            for (int e = 0; e < 4; ++e) { const float s0 = sigmoidf_(x0[e]); k0[e] = k0[e] * (1.f + (s0 - 1.f) * ka0[e]); n0[e] *= s0; }
                            *(v2u*)(km + off) = pack4(k0); *(v2u*)(bb + off) = pack4(n0);
                        } else if (GRP == 2) { *(v2u*)(gg + off) = pack4(x0);
                        } else { f32x4 a0_ = unpack4(*(const v2u*)(vv + off)); const f32x4 f0 = unpack4(*(const v2u*)(vfirst + off));
#pragma unroll
                            for (int e = 0; e < 4; ++e) a0_[e] += (f0[e] - a0_[e]) * sigmoidf_(x0[e]);
                            *(v2u*)(vv + off) = pack4(a0_); }
                        EPI_FENCE(); } }
    }
    __device__ __forceinline__ void operator()(const f32x4 (&acc)[2][2][4][2], const pg8::Unit& u, int wr, int wc, int, int) const { run<GRPT>(acc, u, wr, wc, 0, 0); }
};
struct EpiNull {
    static constexpr bool PERM = false, AFTER_DRAIN = false;
    float* sink;
    __device__ __forceinline__ void operator()(const f32x4 (&acc)[2][2][4][2], const pg8::Unit& u, int wr, int wc, int, int) const {
        float s = 0.f;
#pragma unroll
        for (int ai = 0; ai < 2; ++ai)
#pragma unroll
            for (int bj = 0; bj < 2; ++bj)
#pragma unroll
                for (int m = 0; m < 4; ++m)
#pragma unroll
                    for (int n = 0; n < 2; ++n) s += acc[ai][bj][m][n][0] + acc[ai][bj][m][n][1] + acc[ai][bj][m][n][2] + acc[ai][bj][m][n][3];
        if (s == 12345.678f) sink[0] = s;
    }
};
struct OffOrder {
    pg8::StaticOrder b; int off;
    __device__ bool next(int i, pg8::Unit& u) const { if (!b.next(i, u)) return false; u.pn += off; return true; }
    __device__ __forceinline__ void a_ready(const pg8::Unit&) const {}
    __device__ __forceinline__ void done(const pg8::Unit&) const {}
};
__device__ __forceinline__ void unpack8(const v4u q, float* x);
__device__ __forceinline__ v4u packarr(const float* x);
template <int SECOND> struct EpiUp {
    static constexpr bool PERM = true, AFTER_DRAIN = false;
    unsigned char* ws; const float* gates_base;
    __device__ __forceinline__ void operator()(const f32x4 (&acc)[2][2][4][2], const pg8::Unit& u, int wr, int wc, int, int) const {
        EPI_IDX();
        const int row0 = u.pm * 256 + wr * 64 + fr;
        const bf16* gates = (const bf16*)gates_base; bf16* merged = (bf16*)(ws + WS_MERGED);
#pragma unroll
        for (int ai = 0; ai < 2; ++ai)
#pragma unroll
            for (int m = 0; m < 4; ++m) { const int row = row0 + ai * 128 + m * 16;
#pragma unroll
                for (int bj = 0; bj < 2; ++bj) { const int col = u.pn * 256 + bj * 128 + wc * 32 + 8 * fq;
                    float g[8]; unpack8(*(const v4u*)(gates + (size_t)row * 2048 + SECOND * 1024 + col), g);
                    bf16* mp = merged + (size_t)row * D + col;
                    float o[8];
#pragma unroll
                    for (int e = 0; e < 4; ++e) { o[e] = sigmoidf_(g[e]) * acc[ai][bj][m][0][e]; o[e + 4] = sigmoidf_(g[e + 4]) * acc[ai][bj][m][1][e]; }
                    if (SECOND == 1) { float p[8]; unpack8(*(const v4u*)mp, p);
#pragma unroll
                        for (int e = 0; e < 8; ++e) o[e] += p[e]; }
                    *(v4u*)mp = packarr(o); }
                EPI_FENCE(); }
    }
};

__device__ __forceinline__ void phase_mod(CArgs a, LAS unsigned char* lds, int tid, int bid, int G) {
    LAS float* sc = (LAS float*)lds;
    LAS float* red = (LAS float*)(lds + 32768);
    float* mod = (float*)(a->ws + WS_MOD);
    const float* c = a->in[1];
    bool loaded = false;
    for (int it = bid; it < 144; it += G) {
        if (!loaded) { for (int i = tid; i < 8192; i += 512) { const int b = i >> 10, k = i & 1023; const float v = c[i]; sc[k * 8 + b] = v * sigmoidf_(v); } loaded = true; }
        __syncthreads();
        const int l = it / 36, j0 = (it % 36) * 256, ln = tid & 63, kq = tid >> 6;
        const float* w = a->in[2] + (size_t)l * 1024 * 9216 + j0 + 4 * ln;
        f32x4 a0[4], a1[4];
#pragma unroll
        for (int q = 0; q < 4; ++q) { a0[q] = (f32x4){0.f, 0.f, 0.f, 0.f}; a1[q] = a0[q]; }
#pragma unroll 8
        for (int k = kq * 128; k < kq * 128 + 128; ++k) { const f32x4 wv = *(const f32x4*)(w + (size_t)k * 9216); const f32x4 s0 = *(LAS const f32x4*)(sc + k * 8), s1 = *(LAS const f32x4*)(sc + k * 8 + 4);
#pragma unroll
            for (int q = 0; q < 4; ++q) { a0[q] += wv[q] * s0; a1[q] += wv[q] * s1; } }
#pragma unroll
        for (int q = 0; q < 4; ++q) { *(LAS f32x4*)(red + ((kq * 256 + 4 * ln + q) * 8)) = a0[q]; *(LAS f32x4*)(red + ((kq * 256 + 4 * ln + q) * 8) + 4) = a1[q]; }
        __syncthreads();
        for (int o = tid; o < 2048; o += 512) { const int cc = o >> 3, bq = o & 7; float sum = 0.f;
#pragma unroll
            for (int q = 0; q < 8; ++q) sum += red[(q * 256 + cc) * 8 + bq];
            mod[(size_t)(l * 8 + bq) * 9216 + j0 + cc] = sum + a->in[3][l * 9216 + j0 + cc]; }
        __syncthreads();
    }
}
template <int MAP> __device__ __forceinline__ void tr_item(const float* W, int K, int N, bf16* WT, LAS float* scr, int item, int lane) {
    const int nblk = N / 32, kb = item / nblk, nb = item % nblk, k0 = 64 * kb, n0 = 32 * nb;
    {
        const int nq = (lane & 7) * 4;
#pragma unroll
        for (int i = 0; i < 8; ++i) { const int kk = 8 * i + (lane >> 3); const f32x4 w4 = *(const f32x4*)(W + (size_t)(k0 + kk) * N + n0 + nq);
            LAS float* d = scr + kk * 33 + nq; d[0] = w4.x; d[1] = w4.y; d[2] = w4.z; d[3] = w4.w; } }
    LDS_WAIT();
    const int c = lane & 7;
#pragma unroll
    for (int j = 0; j < 4; ++j) { const int n = (lane >> 3) + 8 * j; const LAS float* s = scr + (8 * c) * 33 + n;
        v4u o; o.x = pk2(s[0 * 33], s[1 * 33]); o.y = pk2(s[2 * 33], s[3 * 33]); o.z = pk2(s[4 * 33], s[5 * 33]); o.w = pk2(s[6 * 33], s[7 * 33]);
        const int nn = n0 + n; const int dr = MAP == 0 ? nn : ((nn >> 7) * 256 + (MAP == 2 ? 128 : 0) + (nn & 127));
        *(v4u*)(WT + (size_t)dr * K + k0 + 8 * c) = o; }
    LDS_WAIT();
}
__device__ __forceinline__ void phase_convert(CArgs a, LAS unsigned char* lds, int l, int gw, int NGW, int wave, int lane, int gtid, int GT) {
    LAS float* scr = (LAS float*)(lds + wave * 16384);
    unsigned char* ws = a->ws;
    const size_t fo = (size_t)l * 1024 * FF;
    const int nin = l == 0 ? 5376 : 5408;
    const float* win = l == 0 ? a->in[8] : a->in[9] + (size_t)(l - 1) * 1024 * 5408;
    const int I_F = 1408, I_IN = 16 * (nin / 32), I_UP = 256, I_OUT = 512;
    const int total = 6 * I_F + I_IN + 2 * I_UP + I_OUT;
    for (int it = gw; it < total; it += NGW) {
        int r = it;
        if (r < I_F) { tr_item<1>(a->in[5] + fo, 1024, FF, (bf16*)(ws + WS_WG1), scr, r, lane); continue; } r -= I_F;
        if (r < I_F) { tr_item<2>(a->in[6] + fo, 1024, FF, (bf16*)(ws + WS_WG1), scr, r, lane); continue; } r -= I_F;
        if (r < I_F) { tr_item<0>(a->in[7] + fo, FF, 1024, (bf16*)(ws + WS_WG2), scr, r, lane); continue; } r -= I_F;
        if (r < I_F) { tr_item<1>(a->in[28] + fo, 1024, FF, (bf16*)(ws + WS_WG1B), scr, r, lane); continue; } r -= I_F;
        if (r < I_F) { tr_item<2>(a->in[29] + fo, 1024, FF, (bf16*)(ws + WS_WG1B), scr, r, lane); continue; } r -= I_F;
        if (r < I_F) { tr_item<0>(a->in[30] + fo, FF, 1024, (bf16*)(ws + WS_WG2B), scr, r, lane); continue; } r -= I_F;
        if (r < I_IN) { tr_item<0>(win, 1024, nin, (bf16*)(ws + WS_WIN), scr, r, lane); continue; } r -= I_IN;
        if (r < I_UP) { tr_item<0>(a->in[25] + (size_t)l * 512 * 1024, 512, 1024, (bf16*)(ws + WS_WUPA), scr, r, lane); continue; } r -= I_UP;
        if (r < I_UP) { tr_item<0>(a->in[26] + (size_t)l * 512 * 1024, 512, 1024, (bf16*)(ws + WS_WUPB), scr, r, lane); continue; } r -= I_UP;
        tr_item<0>(a->in[27] + (size_t)l * 1024 * 1024, 1024, 1024, (bf16*)(ws + WS_WOUT), scr, r, lane);
    }
    bf16* wl = (bf16*)(ws + WS_WLORA);
    for (int ci = gtid; ci < 2048 * 48; ci += GT) { const int n = ci / 48, kc = ci % 48, grp = n >> 9, ch = n & 511; float v[8];
#pragma unroll
        for (int e = 0; e < 8; ++e) { const int kk = kc * 8 + e; float x = 0.f;
            if (grp == 0) { if (kk < 64) x = a->in[12][((size_t)l * 64 + kk) * 512 + ch]; }
            else if (grp == 1) { if (kk >= 64 && kk < 128) x = a->in[14][((size_t)l * 64 + (kk - 64)) * 512 + ch]; }
            else if (grp == 2) { if (kk >= 128 && kk < 256) x = a->in[15][((size_t)l * 128 + (kk - 128)) * 512 + ch]; }
            else { if (l > 0 && kk >= 256 && kk < 288) x = a->in[22][((size_t)(l - 1) * 32 + (kk - 256)) * 512 + ch]; }
            v[e] = x; }
        v4u o; o.x = pk2(v[0], v[1]); o.y = pk2(v[2], v[3]); o.z = pk2(v[4], v[5]); o.w = pk2(v[6], v[7]);
        *(v4u*)(wl + (size_t)n * 384 + kc * 8) = o; }
}
__device__ __forceinline__ void phase_norm(const float* x32, const bf16* h16, const float* g, const float* modl, int i3, bf16* nout, int gw, int NGW, int lane) {
#pragma unroll 2
    for (int m = gw; m < M; m += NGW) { const int b = m >> 12; const float* sh = modl + (size_t)b * 9216 + (3 * i3) * 1024; const float* sc = sh + 1024;
        float v[2][8]; float ss = 0.f;
#pragma unroll
        for (int j = 0; j < 2; ++j) { const int col = 8 * lane + 512 * j;
            if (x32) { const f32x4 a0 = *(const f32x4*)(x32 + (size_t)m * D + col), a1 = *(const f32x4*)(x32 + (size_t)m * D + col + 4);
#pragma unroll
                for (int e = 0; e < 4; ++e) { v[j][e] = a0[e]; v[j][e + 4] = a1[e]; } }
            else unpack8(*(const v4u*)(h16 + (size_t)m * D + col), v[j]);
#pragma unroll
            for (int e = 0; e < 8; ++e) ss += v[j][e] * v[j][e]; }
        const float rstd = __builtin_amdgcn_rsqf(wave_sum(ss, lane) * (1.f / D) + 1e-6f);
#pragma unroll
        for (int j = 0; j < 2; ++j) { const int col = 8 * lane + 512 * j; float y[8];
            const f32x4 g0 = *(const f32x4*)(g + col), g1 = *(const f32x4*)(g + col + 4), s0 = *(const f32x4*)(sc + col), s1 = *(const f32x4*)(sc + col + 4), h0 = *(const f32x4*)(sh + col), h1 = *(const f32x4*)(sh + col + 4);
#pragma unroll
            for (int e = 0; e < 4; ++e) { y[e] = v[j][e] * rstd * g0[e] * (1.f + s0[e]) + h0[e]; y[e + 4] = v[j][e + 4] * rstd * g1[e] * (1.f + s1[e]) + h1[e]; }
            *(v4u*)(nout + (size_t)m * D + col) = packarr(y); } }
}
__device__ __forceinline__ void unpack8(const v4u q, float* x) { x[0] = bflo(q.x); x[1] = bfhi(q.x); x[2] = bflo(q.y); x[3] = bfhi(q.y); x[4] = bflo(q.z); x[5] = bfhi(q.z); x[6] = bflo(q.w); x[7] = bfhi(q.w); }
__device__ __forceinline__ v4u packarr(const float* x) { v4u o; o.x = pk2(x[0], x[1]); o.y = pk2(x[2], x[3]); o.z = pk2(x[4], x[5]); o.w = pk2(x[6], x[7]); return o; }
__device__ __forceinline__ void phase_prep(CArgs a, int l, int gw, int NGW, int lane, const bool do_qk = true) {
    unsigned char* ws = a->ws;
    const bf16* prw = (const bf16*)(ws + WS_PRW);
    bf16 *R = (bf16*)(ws + WS_R), *KM = (bf16*)(ws + WS_KM), *KK = (bf16*)(ws + WS_KK), *VV = (bf16*)(ws + WS_VV), *VF = (bf16*)(ws + WS_VFIRST), *AL = (bf16*)(ws + WS_ALORA);
    const float* mu = a->in[10] + (size_t)l * 1792; const float* kkw = a->in[16] + (size_t)l * 512;
    const v4u z4 = (v4u){0u, 0u, 0u, 0u};
#pragma unroll 2
    for (int m = gw; m < M; m += NGW) { const int s = m & 4095, b = m >> 12; const bool hp = s != 0;
        const bf16* cur = prw + (size_t)m * PRW_LD; const bf16* prv = cur - PRW_LD;
#pragma unroll
        for (int i = 0; i < 3; ++i) { const int col = (lane + 64 * i) * 8; float c[8], p[8], x[8];
            unpack8(*(const v4u*)(cur + col), c); unpack8(hp ? *(const v4u*)(prv + col) : z4, p);
            const f32x4 m0 = *(const f32x4*)(mu + col), m1 = *(const f32x4*)(mu + col + 4);
#pragma unroll
            for (int e = 0; e < 4; ++e) { x[e] = c[e] + (p[e] - c[e]) * m0[e]; x[e + 4] = c[e + 4] + (p[e + 4] - c[e + 4]) * m1[e]; }
            const size_t off = (size_t)m * RW + lane * 8;
            if (i == 0) *(v4u*)(R + off) = packarr(x);
            else if (i == 1) { *(v4u*)(KM + off) = packarr(x); const f32x4 k0 = *(const f32x4*)(kkw + lane * 8), k1 = *(const f32x4*)(kkw + lane * 8 + 4); float ss = 0.f;
#pragma unroll
                for (int e = 0; e < 4; ++e) { x[e] *= k0[e]; x[e + 4] *= k1[e]; ss += x[e] * x[e] + x[e + 4] * x[e + 4]; }
                ss += SHX(ss, 1); ss += SHX(ss, 2); ss += SHX(ss, 4);
                const float inv = fminf(__builtin_amdgcn_rsqf(ss), 1e12f);
#pragma unroll
                for (int e = 0; e < 8; ++e) x[e] *= inv;
                *(v4u*)(KK + off) = packarr(x); }
            else { const v4u o = packarr(x); *(v4u*)(VV + off) = o; if (l == 0) *(v4u*)(VF + off) = o; } }
        if (lane < 48) { float x[8];
            if (lane < 32) { const int col = 1536 + lane * 8; float c[8], p[8];
                unpack8(*(const v4u*)(cur + col), c); unpack8(hp ? *(const v4u*)(prv + col) : z4, p);
#pragma unroll
                for (int e = 0; e < 8; ++e) { const float xx = c[e] + (p[e] - c[e]) * mu[col + e];
                    x[e] = lane < 8 ? (1.f - 2.f * __builtin_amdgcn_rcpf(fexp(2.f * xx) + 1.f)) : (lane < 16 ? xx : sigmoidf_(xx)); } }
            else if (lane < 36 && l > 0) { unpack8(*(const v4u*)(cur + 1792 + (lane - 32) * 8), x); }
            else {
#pragma unroll
                for (int e = 0; e < 8; ++e) x[e] = 0.f; }
            *(v4u*)(AL + (size_t)m * 384 + lane * 8) = packarr(x); }
    }
}
constexpr int SC_T = 32, SC_NP = 16, SC_VEC = 0, SC_SCAL = 9216, SC_V = 9280, SC_BUFF = 9792, SC_BUF = SC_BUFF * 4, SC_YB = 2 * SC_BUF;
__device__ __forceinline__ f32x4 h4(const v2u q) { return (f32x4){bflo(q.x), bfhi(q.x), bflo(q.y), bfhi(q.y)}; }
__device__ __forceinline__ float dot4(const f32x4 a, const f32x4 b) { f32x2 t = (f32x2){a.x, a.y} * (f32x2){b.x, b.y}; t = (f32x2){a.z, a.w} * (f32x2){b.z, b.w} + t; return t.x + t.y; }
__device__ __forceinline__ void scan_unit(CArgs a, LAS unsigned char* lds, int l, int hh, int qq, int tid) {
    unsigned char* ws = a->ws;
    const int b = hh >> 3, h = hh & 7;
    constexpr int NC = S / SC_T;
    if (tid >= 256) {
        const int ht = tid - 256, hp = ht >> 4, hl = ht & 15;
        const size_t goff = ((size_t)b * S + 2 * hp) * RW + h * 64 + hl * 4;
        const bf16 *t0 = (const bf16*)(ws + WS_R) + goff, *t1 = (const bf16*)(ws + WS_WL2) + goff, *t2 = (const bf16*)(ws + WS_KM) + goff, *t3 = (const bf16*)(ws + WS_KK) + goff, *t4 = (const bf16*)(ws + WS_BB) + goff;
        const bf16* t5 = (const bf16*)(ws + WS_VV) + ((size_t)b * S + (ht >> 1)) * RW + h * 64 + 16 * qq + (ht & 1) * 8;
        const int ytok = ht >> 3, ypart = ht & 7;
        bf16* yo = (bf16*)(ws + WS_YA) + ((size_t)b * S + ytok) * RW + h * 64 + 16 * qq + 2 * ypart;
        v2u r0q, r1q, w0q, w1q, k0q, k1q, n0q, n1q, b0q, b1q; v4u vq = (v4u){0u, 0u, 0u, 0u};
#define SC_HLOAD(cc) { const size_t o2 = (size_t)(cc) * SC_T * RW; r0q = *(const v2u*)(t0 + o2); r1q = *(const v2u*)(t0 + o2 + RW); w0q = *(const v2u*)(t1 + o2); w1q = *(const v2u*)(t1 + o2 + RW); \
            k0q = *(const v2u*)(t2 + o2); k1q = *(const v2u*)(t2 + o2 + RW); n0q = *(const v2u*)(t3 + o2); n1q = *(const v2u*)(t3 + o2 + RW); b0q = *(const v2u*)(t4 + o2); b1q = *(const v2u*)(t4 + o2 + RW); \
            if (ht < 64) vq = *(const v4u*)(t5 + o2); }
#define SC_HSTORE(cc) { LAS float* B = (LAS float*)(lds + ((cc) & 1) * SC_BUF); LAS float* vb = B + (hp * 9) * 64 + hl * 4; \
            const f32x4 r0 = h4(r0q), r1 = h4(r1q), k0 = h4(k0q), k1 = h4(k1q), n0 = h4(n0q), n1 = h4(n1q), b0 = h4(b0q), b1 = h4(b1q); f32x4 w0 = h4(w0q), w1 = h4(w1q); \
            _Pragma("unroll") for (int e = 0; e < 4; ++e) { w0[e] = __builtin_amdgcn_exp2f(w0[e]); w1[e] = __builtin_amdgcn_exp2f(w1[e]); } \
            *(LAS f32x4*)(vb) = n0; *(LAS f32x4*)(vb + 64) = w0 * n1; *(LAS f32x4*)(vb + 128) = w0 * w1; *(LAS f32x4*)(vb + 192) = b0 * w1; *(LAS f32x4*)(vb + 256) = k0 * w1; \
            *(LAS f32x4*)(vb + 320) = b1; *(LAS f32x4*)(vb + 384) = k1; *(LAS f32x4*)(vb + 448) = w0 * r0; *(LAS f32x4*)(vb + 512) = r1; \
            const float c1 = -red16(dot4(b0, n1)), c2 = -red16(dot4(k0, n1)), c3 = red16(dot4(b0, r0)), c4 = red16(dot4(k0, r0)); \
            if (hl == 0) *(LAS f32x4*)(B + SC_SCAL + hp * 4) = (f32x4){c1, c2, c3, c4}; \
            if (ht < 64) { float x[8]; unpack8(vq, x); const int vt = ht >> 1; LAS float* d = B + SC_V + ((vt >> 1) * 16 + (ht & 1) * 8) * 2 + (vt & 1); \
                _Pragma("unroll") for (int e = 0; e < 8; ++e) d[2 * e] = x[e]; } }
#define SC_HBAR() { asm volatile("s_waitcnt lgkmcnt(0)" ::: "memory"); __builtin_amdgcn_s_barrier(); asm volatile("" ::: "memory"); }
        SC_HLOAD(0); SC_HSTORE(0); SC_HLOAD(1);
        SC_HBAR();
        for (int c = 0; c < NC; ++c) {
            if (c + 1 < NC) SC_HSTORE(c + 1);
            if (c + 2 < NC) SC_HLOAD(c + 2);
            if (c >= 1) { LAS const float* yb = (LAS const float*)(lds + SC_YB + ((c - 1) & 1) * 2048) + ytok * 16 + 2 * ypart; *(unsigned*)(yo + (size_t)(c - 1) * SC_T * RW) = pk2(yb[0], yb[1]); }
            SC_HBAR();
        }
#undef SC_HLOAD
#undef SC_HSTORE
#undef SC_HBAR
        { LAS const float* yb = (LAS const float*)(lds + SC_YB + ((NC - 1) & 1) * 2048) + ytok * 16 + 2 * ypart; *(unsigned*)(yo + (size_t)(NC - 1) * SC_T * RW) = pk2(yb[0], yb[1]); }
    } else {
        const int row = tid >> 4, ks = tid & 15;
        f32x4 s0 = (f32x4){0.f, 0.f, 0.f, 0.f};
        __syncthreads();
        for (int c = 0; c < NC; ++c) {
            LAS const float* B0 = (LAS const float*)(lds + (c & 1) * SC_BUF);
            LAS float* yb = (LAS float*)(lds + SC_YB + (c & 1) * 2048);
#define SC_LD(P, j_) { const int jl = (j_) < SC_NP ? (j_) : SC_NP - 1; LAS const float* vb = B0 + (jl * 9) * 64 + 4 * ks; \
                P##0 = *(LAS const f32x4*)(vb); P##1 = *(LAS const f32x4*)(vb + 64); P##2 = *(LAS const f32x4*)(vb + 128); P##3 = *(LAS const f32x4*)(vb + 192); P##4 = *(LAS const f32x4*)(vb + 256); \
                P##5 = *(LAS const f32x4*)(vb + 320); P##6 = *(LAS const f32x4*)(vb + 384); P##7 = *(LAS const f32x4*)(vb + 448); P##8 = *(LAS const f32x4*)(vb + 512); \
                P##c = *(LAS const f32x4*)(B0 + SC_SCAL + jl * 4); P##v = *(LAS const f32x2*)(B0 + SC_V + (jl * 16 + row) * 2); }
#define SC_STEP(P, j_) { const float d0 = red16(dot4(s0, P##0)), e1 = red16(dot4(s0, P##1)), g0 = red16(dot4(s0, P##7)); \
                const float sa0 = -d0, sa1 = (sa0 * P##c.x + P##v.x * P##c.y) - e1, y0 = g0 + (sa0 * P##c.z + P##v.x * P##c.w); \
                s0 = s0 * P##2 + (sa0 * P##3 + P##v.x * P##4) + (sa1 * P##5 + P##v.y * P##6); \
                const float y1 = red16(dot4(s0, P##8)); \
                if (ks == 0) { yb[(2 * (j_)) * 16 + row] = y0; yb[(2 * (j_) + 1) * 16 + row] = y1; } }
            f32x4 A0, A1, A2, A3, A4, A5, A6, A7, A8, Ac, B_0, B_1, B_2, B_3, B_4, B_5, B_6, B_7, B_8, B_c; f32x2 Av, B_v;
            SC_LD(A, 0); SC_LD(B_, 1);
#pragma unroll 2
            for (int j = 0; j < SC_NP; j += 2) {
                SC_STEP(A, j); SC_LD(A, j + 2);
                SC_STEP(B_, j + 1); SC_LD(B_, j + 3);
            }
#undef SC_LD
#undef SC_STEP
            __syncthreads();
        }
    }
    __syncthreads();
}
__device__ __forceinline__ void phase_scanfin(CArgs a, int l, int gw, int NGW, int lane, const bool do_store = true) {
    unsigned char* ws = a->ws;
    bf16* YA = (bf16*)(ws + WS_YA); const bf16 *R = (const bf16*)(ws + WS_R), *KM = (const bf16*)(ws + WS_KM), *VV = (const bf16*)(ws + WS_VV), *GG = (const bf16*)(ws + WS_GG);
    const int ch = lane * 8;
    float lw[8], lb[8], rk[8];
#pragma unroll
    for (int e = 0; e < 8; ++e) { lw[e] = a->in[19][l * 512 + ch + e]; lb[e] = a->in[20][l * 512 + ch + e]; rk[e] = a->in[18][l * 512 + ch + e]; }
#pragma unroll 2
    for (int m = gw; m < M; m += NGW) { const size_t off = (size_t)m * RW + ch; float y[8], r[8], k[8], v[8], g[8];
        unpack8(*(const v4u*)(YA + off), y); unpack8(*(const v4u*)(R + off), r); unpack8(*(const v4u*)(KM + off), k); unpack8(*(const v4u*)(VV + off), v); unpack8(*(const v4u*)(GG + off), g);
        float s1 = 0.f, bs = 0.f;
#pragma unroll
        for (int e = 0; e < 8; ++e) { s1 += y[e]; bs += r[e] * k[e] * rk[e]; }
        s1 += SHX(s1, 1); s1 += SHX(s1, 2); s1 += SHX(s1, 4); bs += SHX(bs, 1); bs += SHX(bs, 2); bs += SHX(bs, 4);
        const float mean = s1 * (1.f / 64.f); float s2 = 0.f;
#pragma unroll
        for (int e = 0; e < 8; ++e) { y[e] -= mean; s2 += y[e] * y[e]; }
        s2 += SHX(s2, 1); s2 += SHX(s2, 2); s2 += SHX(s2, 4);
        const float rstd = __builtin_amdgcn_rsqf(s2 * (1.f / 64.f) + 64e-5f);
#pragma unroll
        for (int e = 0; e < 8; ++e) y[e] = (y[e] * rstd * lw[e] + lb[e] + bs * v[e]) * g[e];
        if (do_store || y[0] == 12345.678f) *(v4u*)(YA + off) = packarr(y); }
}
constexpr int AT_BUF = 18432, AT_LDK = 72;
constexpr float AT_EXIT = 64.f;
__device__ __forceinline__ float softplus2(float z) { return fmaxf(z, 0.f) + __builtin_amdgcn_logf(1.f + __builtin_amdgcn_exp2f(-fabsf(z))); }
__device__ __forceinline__ void attn_unit(CArgs a, LAS unsigned char* lds, int l, int bh, int qb, int tid, int wave, int lane) {
    unsigned char* ws = a->ws;
    const bf16* Q = (const bf16*)(ws + WS_Q) + (size_t)bh * S * HD; const bf16* K = (const bf16*)(ws + WS_K) + (size_t)bh * S * HD; const bf16* VT = (const bf16*)(ws + WS_VT) + (size_t)bh * HD * S;
    bf16* YB = (bf16*)(ws + WS_YB);
    const int ql = lane & 31, hi = lane >> 5, qr0 = qb * 256 + wave * 32, qabs = qr0 + ql;
    bf16x8 qf[4];
    {
        const float* qg = a->in[23] + l * 64; float xq[4][8]; float ss = 0.f;
#pragma unroll
        for (int ds = 0; ds < 4; ++ds) { unpack8(*(const v4u*)(Q + (size_t)qabs * HD + 16 * ds + 8 * hi), xq[ds]);
#pragma unroll
            for (int e = 0; e < 8; ++e) ss += xq[ds][e] * xq[ds][e]; }
        const auto rr = __builtin_amdgcn_permlane32_swap(__float_as_uint(ss), __float_as_uint(ss), false, false);
        const float rstd = __builtin_amdgcn_rsqf((__uint_as_float(rr[0]) + __uint_as_float(rr[1])) * (1.f / 64.f) + 1e-6f) * (0.125f * LOG2E);
#pragma unroll
        for (int ds = 0; ds < 4; ++ds) {
#pragma unroll
            for (int e = 0; e < 8; ++e) xq[ds][e] *= rstd * qg[16 * ds + 8 * hi + e];
            qf[ds] = __builtin_bit_cast(bf16x8, packarr(xq[ds])); } }
    f32x16 o0, o1;
#pragma unroll
    for (int r = 0; r < 16; ++r) { o0[r] = 0.f; o1[r] = 0.f; }
    float L = 0.f; float wmin = 0.f;
    const int srow = tid >> 3, spart = tid & 7;
    const f32x4 kg0 = *(const f32x4*)(a->in[24] + l * 64 + spart * 8), kg1 = *(const f32x4*)(a->in[24] + l * 64 + spart * 8 + 4);
#define AT_KNORM(kq_) { float xk[8]; unpack8(kq_, xk); float ss = 0.f; _Pragma("unroll") for (int e = 0; e < 8; ++e) ss += xk[e] * xk[e]; \
        ss += SHX(ss, 1); ss += SHX(ss, 2); ss += SHX(ss, 4); const float rs_ = __builtin_amdgcn_rsqf(ss * (1.f / 64.f) + 1e-6f); \
        _Pragma("unroll") for (int e = 0; e < 4; ++e) { xk[e] *= rs_ * kg0[e]; xk[e + 4] *= rs_ * kg1[e]; } kq_ = packarr(xk); }
    LAS float* lmin = (LAS float*)(lds + MISC_OFF + 64);
    int kt = qb * 4 + 3;
    v4u kq = *(const v4u*)(K + (size_t)(64 * kt + srow) * HD + spart * 8), vq = *(const v4u*)(VT + (size_t)srow * S + 64 * kt + spart * 8);
    AT_KNORM(kq);
    *(LAS v4u*)(lds + srow * (AT_LDK * 2) + spart * 16) = kq; *(LAS v4u*)(lds + 9216 + srow * (AT_LDK * 2) + spart * 16) = vq;
    __syncthreads();
    int cur = 0;
    for (; kt >= 0; --kt) {
        if (kt > 0) { kq = *(const v4u*)(K + (size_t)(64 * (kt - 1) + srow) * HD + spart * 8); vq = *(const v4u*)(VT + (size_t)srow * S + 64 * (kt - 1) + spart * 8); }
        LAS const unsigned char* Ks = lds + cur * AT_BUF; LAS const unsigned char* Vs = Ks + 9216;
        if (64 * kt < qr0 + 31 && wmin <= AT_EXIT) {
            f32x16 p0, p1;
#pragma unroll
            for (int r = 0; r < 16; ++r) { p0[r] = 0.f; p1[r] = 0.f; }
#pragma unroll
            for (int ds = 0; ds < 4; ++ds) { const bf16x8 k0 = *(LAS const bf16x8*)(Ks + ql * (AT_LDK * 2) + ds * 32 + hi * 16), k1 = *(LAS const bf16x8*)(Ks + (32 + ql) * (AT_LDK * 2) + ds * 32 + hi * 16);
                p0 = __builtin_amdgcn_mfma_f32_32x32x16_f16(__builtin_bit_cast(h16x8, k0), __builtin_bit_cast(h16x8, qf[ds]), p0, 0, 0, 0); p1 = __builtin_amdgcn_mfma_f32_32x32x16_f16(__builtin_bit_cast(h16x8, k1), __builtin_bit_cast(h16x8, qf[ds]), p1, 0, 0, 0); }
            const bool need_mask = (64 * kt + 63 >= qr0);
            f32x16 sp0, sp1;
#pragma unroll
            for (int r = 0; r < 16; ++r) { const int kl = (r & 3) + 8 * (r >> 2) + 4 * hi; float a0 = softplus2(p0[r]), a1 = softplus2(p1[r]);
                p0[r] -= a0; p1[r] -= a1;
                if (need_mask) { if (64 * kt + kl >= qabs) { a0 = 0.f; p0[r] = -1e30f; } if (64 * kt + 32 + kl >= qabs) { a1 = 0.f; p1[r] = -1e30f; } }
                sp0[r] = a0; sp1[r] = a1; }
            float off[8]; float run = 0.f;
#pragma unroll
            for (int g = 7; g >= 0; --g) { const float gs = g < 4 ? (sp0[4 * g] + sp0[4 * g + 1]) + (sp0[4 * g + 2] + sp0[4 * g + 3]) : (sp1[4 * g - 16] + sp1[4 * g - 15]) + (sp1[4 * g - 14] + sp1[4 * g - 13]);
                const auto rr = __builtin_amdgcn_permlane32_swap(__float_as_uint(gs), __float_as_uint(gs), false, false);
                const float x0 = __uint_as_float(rr[0]), x1 = __uint_as_float(rr[1]);
                off[g] = run + (hi ? 0.f : x1);
                run += x0 + x1; }
            bf16x8 pf[4];
#pragma unroll
            for (int g = 0; g < 8; ++g) { float e3, e2, e1, e0;
                if (g < 4) { e3 = off[g] + L; e2 = e3 + sp0[4 * g + 3]; e1 = e2 + sp0[4 * g + 2]; e0 = e1 + sp0[4 * g + 1];
                    const float w0 = __builtin_amdgcn_exp2f(p0[4 * g] - e0), w1 = __builtin_amdgcn_exp2f(p0[4 * g + 1] - e1), w2 = __builtin_amdgcn_exp2f(p0[4 * g + 2] - e2), w3 = __builtin_amdgcn_exp2f(p0[4 * g + 3] - e3);
                    const unsigned u0 = pk2(w0, w1), u1 = pk2(w2, w3); const int j = g >> 1, e = (g & 1) * 4;
                    pf[j][e] = (short)(u0 & 0xffff); pf[j][e + 1] = (short)(u0 >> 16); pf[j][e + 2] = (short)(u1 & 0xffff); pf[j][e + 3] = (short)(u1 >> 16); }
                else { const int gg = g - 4; e3 = off[g] + L; e2 = e3 + sp1[4 * gg + 3]; e1 = e2 + sp1[4 * gg + 2]; e0 = e1 + sp1[4 * gg + 1];
                    const float w0 = __builtin_amdgcn_exp2f(p1[4 * gg] - e0), w1 = __builtin_amdgcn_exp2f(p1[4 * gg + 1] - e1), w2 = __builtin_amdgcn_exp2f(p1[4 * gg + 2] - e2), w3 = __builtin_amdgcn_exp2f(p1[4 * gg + 3] - e3);
                    const unsigned u0 = pk2(w0, w1), u1 = pk2(w2, w3); const int j = g >> 1, e = (g & 1) * 4;
                    pf[j][e] = (short)(u0 & 0xffff); pf[j][e + 1] = (short)(u0 >> 16); pf[j][e + 2] = (short)(u1 & 0xffff); pf[j][e + 3] = (short)(u1 >> 16); } }
            L += run;
#pragma unroll
            for (int j = 0; j < 4; ++j) {
                const v2u a00 = *(LAS const v2u*)(Vs + ql * (AT_LDK * 2) + (16 * j + 4 * hi) * 2), a01 = *(LAS const v2u*)(Vs + ql * (AT_LDK * 2) + (16 * j + 8 + 4 * hi) * 2);
                const v2u a10 = *(LAS const v2u*)(Vs + (32 + ql) * (AT_LDK * 2) + (16 * j + 4 * hi) * 2), a11 = *(LAS const v2u*)(Vs + (32 + ql) * (AT_LDK * 2) + (16 * j + 8 + 4 * hi) * 2);
                const v4u A0 = (v4u){a00.x, a00.y, a01.x, a01.y}, A1 = (v4u){a10.x, a10.y, a11.x, a11.y};
                o0 = __builtin_amdgcn_mfma_f32_32x32x16_f16(__builtin_bit_cast(h16x8, A0), __builtin_bit_cast(h16x8, pf[j]), o0, 0, 0, 0);
                o1 = __builtin_amdgcn_mfma_f32_32x32x16_f16(__builtin_bit_cast(h16x8, A1), __builtin_bit_cast(h16x8, pf[j]), o1, 0, 0, 0); }
        }
        float wm = L;
#pragma unroll
        for (int o = 1; o < 64; o <<= 1) wm = fminf(wm, SHX(wm, o));
        wmin = wm;
        if (lane == 0) lmin[wave] = wm;
        __syncthreads();
        float bm = lmin[0];
#pragma unroll
        for (int w = 1; w < 8; ++w) bm = fminf(bm, lmin[w]);
        if (bm > AT_EXIT || kt == 0) break;
        cur ^= 1;
        AT_KNORM(kq);
        *(LAS v4u*)(lds + cur * AT_BUF + srow * (AT_LDK * 2) + spart * 16) = kq; *(LAS v4u*)(lds + cur * AT_BUF + 9216 + srow * (AT_LDK * 2) + spart * 16) = vq;
        __syncthreads();
    }
    const int b = bh >> 3, h = bh & 7;
    bf16* yrow = YB + ((size_t)b * S + qabs) * RW + h * 64;
#pragma unroll
    for (int g = 0; g < 4; ++g) { v2u w; w.x = pk2(o0[4 * g], o0[4 * g + 1]); w.y = pk2(o0[4 * g + 2], o0[4 * g + 3]); *(v2u*)(yrow + 8 * g + 4 * hi) = w;
        w.x = pk2(o1[4 * g], o1[4 * g + 1]); w.y = pk2(o1[4 * g + 2], o1[4 * g + 3]); *(v2u*)(yrow + 32 + 8 * g + 4 * hi) = w; }
    __syncthreads();
}
__device__ __forceinline__ void phase_mixer(CArgs a, LAS unsigned char* lds, int l, const int wave_s) {
    unsigned* ctr = (unsigned*)(a->ws + WS_CTL) + 64 * l; l &= 3;
    volatile LAS unsigned* qw = (volatile LAS unsigned*)(lds + MISC_OFF);
#ifdef PROBE_ATT2
    constexpr int NU = 256 + 2 * 64 * 16;
#else
    constexpr int NU = 256 + 64 * 16;
#endif
    for (;;) {
        const int lane = fresh_lane(), wave = wave_s, tid = wave * 64 + lane;
        if (tid == 0) qw[0] = atomicAdd(ctr, 1u);
        __syncthreads();
        const int u = (int)qw[0];
        __syncthreads();
        if (u >= NU) break;
        if (u < 256) scan_unit(a, lds, l, u >> 2, u & 3, tid);
        else { const int v = (u - 256) & 1023; attn_unit(a, lds, l, v & 63, 15 - (v >> 6), tid, wave, lane); }
    }
}
__device__ __forceinline__ void grid_barrier(unsigned* cnt, unsigned target, const int wave_s) {
    asm volatile("s_waitcnt vmcnt(0) lgkmcnt(0)" ::: "memory");
    __syncthreads();
    if (wave_s * 64 + fresh_lane() == 0) {
        __builtin_amdgcn_fence(__ATOMIC_RELEASE, "agent");
        asm volatile("s_waitcnt vmcnt(0)" ::: "memory");
        __hip_atomic_fetch_add(cnt, 1u, __ATOMIC_RELAXED, __HIP_MEMORY_SCOPE_AGENT);
        while (__hip_atomic_load(cnt, __ATOMIC_RELAXED, __HIP_MEMORY_SCOPE_AGENT) < target) __builtin_amdgcn_s_sleep(2);
        __builtin_amdgcn_fence(__ATOMIC_ACQUIRE, "agent");
        asm volatile("s_waitcnt vmcnt(0)" ::: "memory");
    }
    __syncthreads();
}
__global__ void __launch_bounds__(512, 2) mk_fwd(Args a) {
    extern __shared__ __attribute__((aligned(16))) unsigned char lds_raw[];
    LAS unsigned char* lds = (LAS unsigned char*)lds_raw;
    cg::grid_group grid = cg::this_grid();
    const int wave_k = __builtin_amdgcn_readfirstlane((int)threadIdx.x >> 6);
    grid.sync();
    unsigned bar_round = 0;
    const int ph_lo = a.ph_lo, ph_hi = a.ph_hi;
    for (int ph = ph_lo; ph < ph_hi; ++ph) {
        int bid = blockIdx.x; asm volatile("" : "+s"(bid));
        int wave_s = wave_k; asm volatile("" : "+s"(wave_s));
#define FRESH_TID() const int lane = fresh_lane(), wave = wave_s, tid = wave * 64 + lane, gw = bid * 8 + wave; (void)tid; (void)gw
        CArgs ap = (CArgs)__builtin_amdgcn_kernarg_segment_ptr(); asm volatile("" : "+s"(ap));
        const int G = gridDim.x, NGW = G * 8;
        unsigned char* ws = ap->ws;
        const float* mod = (const float*)(ws + WS_MOD);
        if (ph == 0) {
#ifndef SK_MOD
            FRESH_TID(); phase_mod(ap, lds, tid, bid, G);
#ifdef PROBE_THIN2
            __syncthreads(); phase_mod(ap, lds, tid, bid, G);
#endif
#endif
        }
        else {
            const int l = (ph - 1) / NPH_LAYER, idx = (ph - 1) % NPH_LAYER;
            const float* modl = mod + (size_t)l * 8 * 9216;
            if (0) {}
#ifndef SK_NORM
            else if (idx == 0 || idx == 3 || idx == 11) {
                FRESH_TID();
                if (idx == 0) phase_convert(ap, lds, l, gw, NGW, wave, lane, bid * 512 + tid, G * 512);
#ifdef PROBE_CONV2
                if (idx == 0) { __syncthreads(); phase_convert(ap, lds, l, gw, NGW, wave, lane, bid * 512 + tid, G * 512); }
#endif
                const int i3 = idx == 0 ? 0 : (idx == 3 ? 1 : 2);
                phase_norm((l == 0 && idx == 0) ? ap->in[0] : nullptr, (const bf16*)(ws + WS_H16), ap->in[4] + (size_t)(l * 3 + i3) * 1024, modl, i3, (bf16*)(ws + WS_N), gw, NGW, lane);
#ifdef PROBE_NORM2
                phase_norm((l == 0 && idx == 0) ? ap->in[0] : nullptr, (const bf16*)(ws + WS_H16), ap->in[4] + (size_t)(l * 3 + i3) * 1024, modl, i3, (bf16*)(ws + WS_N), gw, NGW, lane);
#endif
            }
#endif
#ifndef SK_G1
            else if (idx == 1 || idx == 12) {
                pg8::Gemm g{(const pg8::bf16_t*)(ws + WS_N), (const pg8::bf16_t*)(ws + (idx == 1 ? WS_WG1 : WS_WG1B)), M, 2 * FF, D}; pg8::StaticOrder So; So.init(M, 2 * FF, G, bid);
                EpiSwiglu E{(bf16*)(ws + WS_ACT)};
                pg8::gemm_phase<EpiSwiglu, pg8::StaticOrder, true, true>(lds, g, So, E, wave_s);
#ifdef PROBE_G1X2
                __syncthreads(); pg8::gemm_phase<EpiSwiglu, pg8::StaticOrder, true, true>(lds, g, So, E, wave_s);
#endif
#ifdef PROBE_G1X2B
                ++bar_round; grid_barrier((unsigned*)(ap->ws + WS_CTL) + 512, bar_round * (unsigned)G, wave_s);
                pg8::gemm_phase<EpiSwiglu, pg8::StaticOrder, true, true>(lds, g, So, E, wave_s);
#endif
            }
#endif
#ifndef SK_G2
            else if (idx == 2 || idx == 10 || idx == 13) {
                const bf16* A = (const bf16*)(ws + (idx == 10 ? WS_MERGED : WS_ACT)); const bf16* Bt = (const bf16*)(ws + (idx == 2 ? WS_WG2 : (idx == 10 ? WS_WOUT : WS_WG2B)));
                pg8::Gemm g{A, Bt, M, D, idx == 10 ? D : FF}; pg8::StaticOrder So; So.init(M, D, G, bid);
                EpiResid E{ap, l, idx};
#ifdef PROBE_G2NULL
                { EpiNull En{(float*)(ws + WS_CTL) + 900}; pg8::gemm_phase<EpiNull, pg8::StaticOrder, true, true>(lds, g, So, En, wave_s); __syncthreads(); }
#endif
                pg8::gemm_phase<EpiResid, pg8::StaticOrder, true, true>(lds, g, So, E, wave_s);
            }
#endif
#ifndef SK_IN
            else if (idx == 4) {
                const int nn = l == 0 ? 5376 : 5632;
                pg8::Gemm g{(const bf16*)(ws + WS_N), (const bf16*)(ws + WS_WIN), M, nn, D}; pg8::StaticOrder So; So.init(M, nn, G, bid);
                EpiIn E{ws, ap->out};
                pg8::gemm_phase<EpiIn, pg8::StaticOrder, true, true>(lds, g, So, E, wave_s);
#ifdef PROBE_IN2
                __syncthreads(); pg8::gemm_phase<EpiIn, pg8::StaticOrder, true, true>(lds, g, So, E, wave_s);
#endif
#ifdef PROBE_ALLB
                ++bar_round; grid_barrier((unsigned*)(ap->ws + WS_CTL) + 512, bar_round * (unsigned)G, wave_s); pg8::gemm_phase<EpiIn, pg8::StaticOrder, true, true>(lds, g, So, E, wave_s);
#endif
            }
#endif
#ifndef SK_PREP
            else if (idx == 5) {
                FRESH_TID(); phase_prep(ap, l, gw, NGW, lane);
#ifdef PROBE_THIN2
                phase_prep(ap, l, gw, NGW, lane, false);
#endif
            }
#endif
#ifndef SK_LORA
            else if (idx == 6) {
                pg8::Gemm g{(const bf16*)(ws + WS_ALORA), (const bf16*)(ws + WS_WLORA), M, 2048, 384};
                OffOrder So; So.b.init(M, 512, G, bid);
                So.off = 0; { EpiLora<0> E{ap, l}; pg8::gemm_phase<EpiLora<0>, OffOrder, true, true>(lds, g, So, E, wave_s); } __syncthreads();
#ifdef PROBE_LORA2
                So.off = 0; { EpiLora<0> E{ap, l}; pg8::gemm_phase<EpiLora<0>, OffOrder, true, true>(lds, g, So, E, wave_s); } __syncthreads();
                So.off = 4; { EpiLora<2> E{ap, l}; pg8::gemm_phase<EpiLora<2>, OffOrder, true, true>(lds, g, So, E, wave_s); } __syncthreads();
#endif
                So.off = 2; { EpiLora<1> E{ap, l}; pg8::gemm_phase<EpiLora<1>, OffOrder, true, true>(lds, g, So, E, wave_s); } __syncthreads();
                So.off = 4; { EpiLora<2> E{ap, l}; pg8::gemm_phase<EpiLora<2>, OffOrder, true, true>(lds, g, So, E, wave_s); } __syncthreads();
                if (l > 0) { So.off = 6; EpiLora<3> E{ap, l}; pg8::gemm_phase<EpiLora<3>, OffOrder, true, true>(lds, g, So, E, wave_s); }
            }
#endif
#ifndef SK_MIX
            else if (idx == 7) {
                phase_mixer(ap, lds, l, wave_s);
#ifdef PROBE_MIX2
                ++bar_round; grid_barrier((unsigned*)(ap->ws + WS_CTL) + 512, bar_round * (unsigned)G, wave_s); phase_mixer(ap, lds, l + 4, wave_s);
#endif
            }
#endif
#ifndef SK_UP
            else if (idx == 8) { FRESH_TID();
#ifdef PROBE_THIN2
                phase_scanfin(ap, l, gw, NGW, lane, false);
#endif
                phase_scanfin(ap, l, gw, NGW, lane); }
            else if (idx == 9) {
#if defined(PROBE_UP2) || defined(PROBE_ALLB)
              for (int rep = 0; rep < 2; ++rep) {
#endif
                { pg8::Gemm g{(const bf16*)(ws + WS_YA), (const bf16*)(ws + WS_WUPA), M, D, RW}; pg8::StaticOrder So; So.init(M, D, G, bid);
                  EpiUp<0> E{ws, ap->out};
                  pg8::gemm_phase<EpiUp<0>, pg8::StaticOrder, true, true>(lds, g, So, E, wave_s); }
                __syncthreads();
                { pg8::Gemm g{(const bf16*)(ws + WS_YB), (const bf16*)(ws + WS_WUPB), M, D, RW}; pg8::StaticOrder So; So.init(M, D, G, bid);
                  EpiUp<1> E{ws, ap->out};
                  pg8::gemm_phase<EpiUp<1>, pg8::StaticOrder, true, true>(lds, g, So, E, wave_s); }
#ifdef PROBE_UP2
                __syncthreads(); }
#endif
#ifdef PROBE_ALLB
                if (rep == 0) { ++bar_round; grid_barrier((unsigned*)(ap->ws + WS_CTL) + 512, bar_round * (unsigned)G, wave_s); } }
#endif
            }
#endif
        }
        if (ph + 1 < ph_hi) { ++bar_round; grid_barrier((unsigned*)(ap->ws + WS_CTL) + 512, bar_round * (unsigned)G, wave_s); }
#ifdef PROBE_BAR2
        if (ph + 1 < ph_hi) { ++bar_round; grid_barrier((unsigned*)(ap->ws + WS_CTL) + 512, bar_round * (unsigned)G, wave_s); }
#endif
    }
}

extern "C" void kernel_launch(void* const* d_in, const int* in_sizes, int n_in, void* d_out, int out_size, void* d_ws, size_t ws_size, hipStream_t stream) {
    static int grid = 0;
    if (grid == 0) {
        if (n_in != 31 || out_size != M * D || ws_size < WS_END) { fprintf(stderr, "kernel_launch: unexpected shapes (n_in %d, out %d, ws %zu < %zu)\n", n_in, out_size, ws_size, (size_t)WS_END); grid = -1; return; }
        int dev = 0, cus = 0, per_cu = 0;
        hipGetDevice(&dev); hipDeviceGetAttribute(&cus, hipDeviceAttributeMultiprocessorCount, dev);
        hipFuncSetAttribute((const void*)mk_fwd, hipFuncAttributeMaxDynamicSharedMemorySize, LDS_BYTES);
        hipOccupancyMaxActiveBlocksPerMultiprocessor(&per_cu, (const void*)mk_fwd, 512, LDS_BYTES);
        (void)hipGetLastError();
        if (per_cu < 1) per_cu = 1;
        grid = cus * per_cu;
    }
    if (grid < 0) return;
    hipMemsetAsync((char*)d_ws + WS_CTL, 0, 4096, stream);
    Args a{};
    for (int i = 0; i < 31; ++i) a.in[i] = (const float*)d_in[i];
    a.out = (float*)d_out; a.ws = (unsigned char*)d_ws; a.ph_lo = 0; a.ph_hi = NPHASES;
    void* args[] = {&a};
    hipError_t e = hipLaunchCooperativeKernel((const void*)mk_fwd, dim3(grid), dim3(512), args, LDS_BYTES, stream);
    if (e != hipSuccess) fprintf(stderr, "cooperative launch failed: %s (grid %d)\n", hipGetErrorString(e), grid);
}
```

```cpp
#include <hip/hip_runtime.h>
#include <hip/hip_cooperative_groups.h>
#include <cstdio>
#include <cstdint>
namespace cg = cooperative_groups;
namespace pg8 {
#define PG8_LAS __attribute__((address_space(3)))
typedef unsigned short bf16_t;
typedef _Float16 pg8_h8 __attribute__((ext_vector_type(8)));
typedef short bf16x8 __attribute__((ext_vector_type(8)));
typedef float f32x4 __attribute__((ext_vector_type(4)));
typedef unsigned u32x4 __attribute__((ext_vector_type(4)));
constexpr int BM = 256, BK = 64, HALF = 128, HTB = HALF * BK * 2  , STAGE_BYTES = 8 * HTB, NXCD = 8, WGM = 8;

__host__ __device__ __forceinline__ int lds_byte(int r, int c) { const int st = (r >> 4) * 2 + (c >> 5), rr = r & 15, cc = c & 31, ob = rr * 64 + cc * 2; return st * 1024 + (ob ^ (((ob >> 9) & 1) << 5)); }
__host__ __device__ __forceinline__ void stage_rc(int b, int& R, int& C) { const int st = b / 1024, sb = b % 1024, swz = sb ^ (((sb >> 9) & 1) << 5); R = (st >> 1) * 16 + swz / 64; C = (st & 1) * 32 + (swz % 64) / 2; }
__host__ __device__ __forceinline__ int perm32(int rho) { const int n = rho >> 4, i = rho & 15; return 8 * (i >> 2) + 4 * n + (i & 3); }

struct Unit { int pm, pn; };
struct Gemm { const bf16_t* A; const bf16_t* Bt; int M, N, K; };

struct StaticOrder {
    int nM, nN, nwg, G, c, wgm;
    __host__ __device__ void init(int M, int N, int G_, int c_, int wgm_ = 4) { nM = M / BM; nN = N / BM; nwg = nM * nN; G = G_; c = c_; wgm = wgm_; }
    __host__ __device__ bool next(int i, Unit& u) const {
        const long L = (long)i * G + c; if (L >= nwg) return false;
        int wgid = (int)L; { const int q = nwg / NXCD, r = nwg % NXCD, xcd = wgid % NXCD, off = wgid / NXCD; wgid = (xcd < r ? xcd * (q + 1) : r * (q + 1) + (xcd - r) * q) + off; }
        const int nig = wgm * nN, gid = wgid / nig, fm = gid * wgm, gsz = (nM - fm) < wgm ? (nM - fm) : wgm;
        u.pm = fm + ((wgid % nig) % gsz); u.pn = (wgid % nig) / gsz; return true;
    }
    __device__ __forceinline__ void a_ready(const Unit&) const {}
    __device__ __forceinline__ void done(const Unit&) const {}
};

__device__ __forceinline__ unsigned cvt_pk_bf16(float lo, float hi) { unsigned r; asm volatile("v_cvt_pk_bf16_f32 %0, %1, %2" : "=v"(r) : "v"(lo), "v"(hi)); return r; }
template <class Epi, class Sched, bool ALIGN_EPI = false, bool SP2 = false>
__device__ __forceinline__ void gemm_phase(PG8_LAS unsigned char* lds, const Gemm g, const Sched& S, const Epi& E, const int wave_s) {
    int lane_; asm volatile("v_mbcnt_lo_u32_b32 %0, -1, 0\n\tv_mbcnt_hi_u32_b32 %0, -1, %0" : "=v"(lane_));
    const int wid = wave_s, lane = lane_, tid = wid * 64 + lane, wr = wid >> 2, wc = wid & 3, fr = lane & 15, fq = lane >> 4;
    const int K = g.K, nt = K / BK;
    unsigned voffA[2], voffB[2];
#pragma unroll
    for (int i = 0; i < 2; ++i) { int R, C; stage_rc(tid * 16 + i * 8192, R, C); const int Rb = Epi::PERM ? ((R & ~31) + perm32(R & 31)) : R;
        voffA[i] = (unsigned)(R * K + C) * 2u; voffB[i] = (unsigned)(Rb * K + C) * 2u; }
    const size_t kstep = (size_t)(BK * 2);
    const size_t hstep = (size_t)HALF * K * 2;
    const size_t tstep = 2 * hstep;
    const unsigned ldsw = (unsigned)wid * 1024u;
    const int aoff = lds_byte(wr * 64 + fr, fq * 8), boff = lds_byte(wc * 32 + fr, fq * 8);
#define PG8_SA(b, h) (((b) * 2 + (h)) * HTB)
#define PG8_SB(b, h) ((4 + (b) * 2 + (h)) * HTB)
#define PG8_STAGE(bufoff, gbase, voff) do { _Pragma("unroll") for (int _i = 0; _i < 2; ++_i) \
        __builtin_amdgcn_global_load_lds((const unsigned*)((const char*)(gbase) + (voff)[_i]), (PG8_LAS unsigned*)(lds + (bufoff) + ldsw + _i * 8192), 16, 0, 0); } while (0)
#define PG8_LDA(dst, b, h) do { _Pragma("unroll") for (int m = 0; m < 4; ++m) _Pragma("unroll") for (int k = 0; k < 2; ++k) dst[m][k] = *(const PG8_LAS bf16x8*)(lds + PG8_SA(b, h) + aoff + m * 2048 + k * 1024); } while (0)
#define PG8_LDB(dst, b, h) do { _Pragma("unroll") for (int n = 0; n < 2; ++n) _Pragma("unroll") for (int k = 0; k < 2; ++k) dst[n][k] = *(const PG8_LAS bf16x8*)(lds + PG8_SB(b, h) + boff + n * 2048 + k * 1024); } while (0)
#define PG8_MMA(ai, bj, At, Bt) do { __builtin_amdgcn_s_setprio(1); _Pragma("unroll") for (int m = 0; m < 4; ++m) _Pragma("unroll") for (int n = 0; n < 2; ++n) _Pragma("unroll") for (int k = 0; k < 2; ++k) \
        acc[ai][bj][m][n] = __builtin_amdgcn_mfma_f32_16x16x32_f16(__builtin_bit_cast(pg8_h8, Bt[n][k]), __builtin_bit_cast(pg8_h8, At[m][k]), acc[ai][bj][m][n], 0, 0, 0); __builtin_amdgcn_s_setprio(0); } while (0)
#define PG8_WAIT_V(n) asm volatile("s_waitcnt vmcnt(" #n ")" ::: "memory")
#define PG8_WAIT_L(n) asm volatile("s_waitcnt lgkmcnt(" #n ")" ::: "memory")
#define PG8_BAR __builtin_amdgcn_s_barrier()
#define PG8_SCHED __builtin_amdgcn_sched_barrier(0)
    Unit cur, nxt; int ui = 0;
    if (!S.next(0, cur)) return;
    f32x4 acc[2][2][4][2];
#pragma unroll
    for (int a = 0; a < 2; ++a)
#pragma unroll
        for (int b = 0; b < 2; ++b)
#pragma unroll
            for (int m = 0; m < 4; ++m)
#pragma unroll
                for (int n = 0; n < 2; ++n) acc[a][b][m][n] = (f32x4){0.f, 0.f, 0.f, 0.f};
    bf16x8 At[4][2], B0[2][2], B1[2][2];
    const char* cA = (const char*)g.A + (size_t)cur.pm * tstep; const char* cB = (const char*)g.Bt + (size_t)cur.pn * tstep;
    S.a_ready(cur);
    if constexpr (SP2) {
        PG8_STAGE(PG8_SB(0, 0), cB, voffB); PG8_STAGE(PG8_SB(0, 1), cB + hstep, voffB); PG8_STAGE(PG8_SA(0, 0), cA, voffA); PG8_STAGE(PG8_SA(0, 1), cA + hstep, voffA);
        if (wr == 1) PG8_BAR;
        PG8_WAIT_V(2); PG8_BAR;
        PG8_STAGE(PG8_SB(1, 0), cB + kstep, voffB); PG8_STAGE(PG8_SA(1, 0), cA + kstep, voffA); PG8_STAGE(PG8_SB(1, 1), cB + hstep + kstep, voffB);
        PG8_WAIT_V(6); PG8_BAR;
    } else {
        PG8_STAGE(PG8_SB(0, 0), cB, voffB); PG8_STAGE(PG8_SA(0, 0), cA, voffA); PG8_STAGE(PG8_SB(0, 1), cB + hstep, voffB); PG8_STAGE(PG8_SA(0, 1), cA + hstep, voffA);
        if (wr == 1) PG8_BAR;
        PG8_WAIT_V(4); PG8_BAR;
        PG8_STAGE(PG8_SB(1, 0), cB + kstep, voffB); PG8_STAGE(PG8_SA(1, 0), cA + kstep, voffA); PG8_STAGE(PG8_SB(1, 1), cB + hstep + kstep, voffB);
        PG8_WAIT_V(6); PG8_BAR;
    }
    for (;;) {
        const bool has_next = S.next(ui + 1, nxt);
        const char* nA = has_next ? (const char*)g.A + (size_t)nxt.pm * tstep : cA; const char* nB = has_next ? (const char*)g.Bt + (size_t)nxt.pn * tstep : cB;
        for (int t = 0; t < nt; t += 2) {
            const bool last = (t == nt - 2);
            const char* a1 = cA + (size_t)(t + 1) * kstep;
            const char* a2 = last ? nA : cA + (size_t)(t + 2) * kstep; const char* b2 = last ? nB : cB + (size_t)(t + 2) * kstep;
            const char* a3 = a2 + kstep; const char* b3 = b2 + kstep;
            if (last && has_next) S.a_ready(nxt);
            if constexpr (SP2) {
            PG8_LDB(B0, 0, 0); PG8_LDB(B1, 0, 1); PG8_SCHED; PG8_LDA(At, 0, 0); PG8_STAGE(PG8_SA(1, 1), a1 + hstep, voffA);
            PG8_WAIT_V(8); PG8_WAIT_L(0); PG8_BAR; PG8_MMA(0, 0, At, B0); PG8_MMA(0, 1, At, B1); PG8_BAR; PG8_SCHED;
            PG8_LDA(At, 0, 1); PG8_STAGE(PG8_SB(0, 0), b2, voffB); PG8_STAGE(PG8_SB(0, 1), b2 + hstep, voffB); PG8_STAGE(PG8_SA(0, 0), a2, voffA);
            PG8_WAIT_V(8); PG8_WAIT_L(0); PG8_BAR; PG8_MMA(1, 0, At, B0); PG8_MMA(1, 1, At, B1); PG8_BAR; PG8_SCHED;
            PG8_LDB(B0, 1, 0); PG8_LDB(B1, 1, 1); PG8_SCHED; PG8_LDA(At, 1, 0); PG8_STAGE(PG8_SA(0, 1), a2 + hstep, voffA);
            PG8_WAIT_V(8); PG8_WAIT_L(0); PG8_BAR; PG8_MMA(0, 0, At, B0); PG8_MMA(0, 1, At, B1); PG8_BAR; PG8_SCHED;
            PG8_LDA(At, 1, 1); PG8_STAGE(PG8_SB(1, 0), b3, voffB); PG8_STAGE(PG8_SB(1, 1), b3 + hstep, voffB); PG8_STAGE(PG8_SA(1, 0), a3, voffA);
            PG8_WAIT_V(8); PG8_WAIT_L(0); PG8_BAR; PG8_MMA(1, 0, At, B0); PG8_MMA(1, 1, At, B1); PG8_BAR; PG8_SCHED;
            } else {
            PG8_LDB(B0, 0, 0); PG8_SCHED; PG8_LDA(At, 0, 0); PG8_STAGE(PG8_SA(1, 1), a1 + hstep, voffA);
            PG8_WAIT_L(8); PG8_BAR; PG8_WAIT_L(0); PG8_MMA(0, 0, At, B0); PG8_BAR; PG8_SCHED;
            PG8_LDB(B1, 0, 1); PG8_STAGE(PG8_SB(0, 0), b2, voffB);
            PG8_BAR; PG8_WAIT_L(0); PG8_MMA(0, 1, At, B1); PG8_BAR;
            PG8_LDA(At, 0, 1); PG8_STAGE(PG8_SA(0, 0), a2, voffA);
            PG8_BAR; PG8_WAIT_L(0); PG8_MMA(1, 0, At, B0); PG8_BAR; PG8_SCHED;
            PG8_STAGE(PG8_SB(0, 1), b2 + hstep, voffB);
            PG8_WAIT_V(6); PG8_BAR; PG8_MMA(1, 1, At, B1); PG8_BAR;
            PG8_LDB(B0, 1, 0); PG8_SCHED; PG8_LDA(At, 1, 0); PG8_STAGE(PG8_SA(0, 1), a2 + hstep, voffA);
            PG8_WAIT_L(8); PG8_BAR; PG8_WAIT_L(0); PG8_MMA(0, 0, At, B0); PG8_BAR; PG8_SCHED;
            PG8_LDB(B1, 1, 1); PG8_STAGE(PG8_SB(1, 0), b3, voffB);
            PG8_BAR; PG8_WAIT_L(0); PG8_MMA(0, 1, At, B1); PG8_BAR;
            PG8_LDA(At, 1, 1); PG8_STAGE(PG8_SA(1, 0), a3, voffA);
            PG8_BAR; PG8_WAIT_L(0); PG8_MMA(1, 0, At, B0); PG8_BAR; PG8_SCHED;
            PG8_STAGE(PG8_SB(1, 1), b3 + hstep, voffB);
            PG8_WAIT_V(6); PG8_BAR; PG8_MMA(1, 1, At, B1); PG8_BAR;
            }
        }
        if constexpr (ALIGN_EPI) { if (wr == 0) PG8_BAR; }
        if constexpr (!Epi::AFTER_DRAIN) { E(acc, cur, wr, wc, fr, fq); S.done(cur); }
        if (!has_next) break;
#pragma unroll
        for (int a = 0; a < 2; ++a)
#pragma unroll
            for (int b = 0; b < 2; ++b)
#pragma unroll
                for (int m = 0; m < 4; ++m)
#pragma unroll
                    for (int n = 0; n < 2; ++n) acc[a][b][m][n] = (f32x4){0.f, 0.f, 0.f, 0.f};
        cur = nxt; cA = nA; cB = nB; ++ui;
        if constexpr (ALIGN_EPI) { if (wr == 1) PG8_BAR; }
    }
    PG8_WAIT_V(0);
    if constexpr (!ALIGN_EPI) { if (wr == 0) PG8_BAR; }
    PG8_BAR;
    if constexpr (Epi::AFTER_DRAIN) { E.fused(acc, cur, wr, wc, fr, fq, lds, wid, lane); S.done(cur); }
#undef PG8_SA
#undef PG8_SB
#undef PG8_STAGE
#undef PG8_LDA
#undef PG8_LDB
#undef PG8_MMA
#undef PG8_WAIT_V
#undef PG8_WAIT_L
#undef PG8_BAR
#undef PG8_SCHED
}
}
#define LAS __attribute__((address_space(3)))
typedef unsigned short bf16;
typedef unsigned v4u __attribute__((ext_vector_type(4)));
typedef unsigned v2u __attribute__((ext_vector_type(2)));
typedef float f32x4 __attribute__((ext_vector_type(4)));
typedef float f32x2 __attribute__((ext_vector_type(2)));
typedef float f32x16 __attribute__((ext_vector_type(16)));
typedef short bf16x8 __attribute__((ext_vector_type(8)));

constexpr int NB = 8, S = 4096, M = NB * S, D = 1024, FF = 2816, NH = 8, HD = 64, RW = 512;
constexpr int PRW_LD = 1824, NPH_LAYER = 14, NPHASES = 1 + 4 * NPH_LAYER;
constexpr float LOG2E = 1.4426950408889634f, LN2 = 0.6931471805599453f;
constexpr size_t MiB = 1u << 20, HM = MiB / 2;
constexpr size_t WS_CTL = 0, WS_MOD = 1 * MiB;
constexpr size_t WS_WG1 = 3 * MiB, WS_WG2 = 14 * MiB, WS_WIN = 19 * MiB + HM, WS_WUPA = 30 * MiB + HM, WS_WUPB = 31 * MiB + HM, WS_WOUT = 32 * MiB + HM,
                 WS_WG1B = 34 * MiB + HM, WS_WG2B = 45 * MiB + HM, WS_WLORA = 51 * MiB;
constexpr size_t WS_PRW = 53 * MiB, WS_Q = 167 * MiB, WS_K = 199 * MiB, WS_VT = 231 * MiB, WS_H16 = 263 * MiB, WS_ACT = 53 * MiB;
constexpr size_t WS_WL2 = 53 * MiB, WS_BB = 85 * MiB, WS_GG = 117 * MiB, WS_MERGED = 53 * MiB;
constexpr size_t WS_R = 391 * MiB, WS_KM = 423 * MiB, WS_KK = 455 * MiB, WS_VV = 487 * MiB, WS_N = 391 * MiB, WS_TEMP = 391 * MiB;
constexpr size_t WS_YA = 519 * MiB, WS_YB = 551 * MiB, WS_ALORA = 519 * MiB, WS_VFIRST = 583 * MiB, WS_END = 615 * MiB;
constexpr int LDS_BYTES = 147456, MISC_OFF = 131072;

typedef _Float16 h16x2 __attribute__((ext_vector_type(2)));
typedef _Float16 h16x8 __attribute__((ext_vector_type(8)));
__device__ __forceinline__ unsigned f2bf(float f) { return (unsigned)__builtin_bit_cast(unsigned short, (_Float16)f); }
__device__ __forceinline__ unsigned pk2(float lo, float hi) { const h16x2 v = {(_Float16)lo, (_Float16)hi}; return __builtin_bit_cast(unsigned, v); }
__device__ __forceinline__ float bflo(unsigned u) { const h16x2 v = __builtin_bit_cast(h16x2, u); return (float)v.x; }
__device__ __forceinline__ float bfhi(unsigned u) { const h16x2 v = __builtin_bit_cast(h16x2, u); return (float)v.y; }
__device__ __forceinline__ float fexp(float x) { return __builtin_amdgcn_exp2f(x * LOG2E); }
__device__ __forceinline__ float flog(float x) { return __builtin_amdgcn_logf(x) * LN2; }
__device__ __forceinline__ float sigmoidf_(float x) { return __builtin_amdgcn_rcpf(1.f + fexp(-x)); }
#define SHX(v, o) __uint_as_float(__builtin_amdgcn_ds_bpermute(((lane) ^ (o)) << 2, __float_as_uint(v)))
__device__ __forceinline__ float wave_sum(float v, int lane) {
#pragma unroll
    for (int o = 1; o < 64; o <<= 1) v += SHX(v, o);
    return v;
}
template <int CTRL> __device__ __forceinline__ float dppf(float x) { return __uint_as_float(__builtin_amdgcn_update_dpp(0u, __float_as_uint(x), CTRL, 0xf, 0xf, false)); }
__device__ __forceinline__ float red16(float x) { x += dppf<0x128>(x); x += dppf<0x124>(x); x += dppf<0x122>(x); x += dppf<0x121>(x); return x; }
#define LDS_WAIT() asm volatile("s_waitcnt lgkmcnt(0)" ::: "memory")

struct Args { const float* in[31]; float* out; unsigned char* ws; int ph_lo, ph_hi; };
typedef const __attribute__((address_space(4))) Args* CArgs;
#define EPI_FENCE() asm volatile("" ::: "memory")

__device__ __forceinline__ int fresh_lane() { int ln; asm volatile("v_mbcnt_lo_u32_b32 %0, -1, 0\n\tv_mbcnt_hi_u32_b32 %0, -1, %0" : "=v"(ln)); return ln; }
#define EPI_IDX() const int t_ = fresh_lane(); const int fr = t_ & 15, fq = t_ >> 4
__device__ __forceinline__ v4u pack8(const f32x4 a, const f32x4 b);
struct EpiSwiglu {
    static constexpr bool PERM = true, AFTER_DRAIN = false;
    bf16* act;
    __device__ __forceinline__ void operator()(const f32x4 (&acc)[2][2][4][2], const pg8::Unit& u, int wr, int wc, int, int) const {
        EPI_IDX();
        const int row0 = u.pm * 256 + wr * 64 + fr, f0 = u.pn * 128 + wc * 32 + fq * 8;
#pragma unroll
        for (int ai = 0; ai < 2; ++ai)
#pragma unroll
            for (int m = 0; m < 4; ++m) { bf16* rp = act + (size_t)(row0 + ai * 128 + m * 16) * FF + f0; f32x4 o[2];
#pragma unroll
                for (int n = 0; n < 2; ++n) { const f32x4 g = acc[ai][0][m][n], uu = acc[ai][1][m][n];
#pragma unroll
                    for (int j = 0; j < 4; ++j) o[n][j] = g[j] * uu[j] * __builtin_amdgcn_rcpf(1.f + __builtin_amdgcn_exp2f(-g[j] * LOG2E)); }
                *(v4u*)rp = pack8(o[0], o[1]);
                EPI_FENCE(); }
    }
};
struct EpiResid {
    static constexpr bool PERM = true, AFTER_DRAIN = false;
    CArgs a; int l, idx;
    __device__ __forceinline__ void operator()(const f32x4 (&acc)[2][2][4][2], const pg8::Unit& u, int wr, int wc, int, int) const {
        EPI_IDX();
        unsigned char* ws = a->ws; const float* mod = (const float*)(ws + WS_MOD);
        const bool in32 = (l == 0 && idx == 2), out32 = (l == 3 && idx == 13);
        const float* x32 = a->in[0]; float* o32 = a->out; bf16* h16 = (bf16*)(ws + WS_H16);
        const float* gt = mod + (size_t)l * 8 * 9216 + (idx == 2 ? 2 : (idx == 10 ? 5 : 8)) * 1024; const float fac = idx == 10 ? 1.f : 0.5f;
        const int row0 = u.pm * 256 + wr * 64 + fr, col0 = u.pn * 256 + wc * 32 + 8 * fq, b = u.pm >> 4;
#pragma unroll
        for (int bj = 0; bj < 2; ++bj) { const int col = col0 + bj * 128; const f32x4 g0 = *(const f32x4*)(gt + b * 9216 + col) * fac, g1 = *(const f32x4*)(gt + b * 9216 + col + 4) * fac;
#pragma unroll
            for (int ai = 0; ai < 2; ++ai)
#pragma unroll
                for (int m = 0; m < 4; ++m) { const size_t off = (size_t)(row0 + ai * 128 + m * 16) * D + col; f32x4 h0, h1;
                    if (in32) { h0 = *(const f32x4*)(x32 + off); h1 = *(const f32x4*)(x32 + off + 4); }
                    else { const v4u q = *(const v4u*)(h16 + off); h0 = (f32x4){bflo(q.x), bfhi(q.x), bflo(q.y), bfhi(q.y)}; h1 = (f32x4){bflo(q.z), bfhi(q.z), bflo(q.w), bfhi(q.w)}; }
                    const f32x4 o0 = h0 + g0 * acc[ai][bj][m][0], o1 = h1 + g1 * acc[ai][bj][m][1];
                    if (out32) { *(f32x4*)(o32 + off) = o0; *(f32x4*)(o32 + off + 4) = o1; }
                    else { v4u w; w.x = pk2(o0[0], o0[1]); w.y = pk2(o0[2], o0[3]); w.z = pk2(o1[0], o1[1]); w.w = pk2(o1[2], o1[3]); *(v4u*)(h16 + off) = w; }
                    if (m & 1) EPI_FENCE(); } }
    }
};
__device__ __forceinline__ v4u pack8(const f32x4 a, const f32x4 b) { v4u w; w.x = pk2(a[0], a[1]); w.y = pk2(a[2], a[3]); w.z = pk2(b[0], b[1]); w.w = pk2(b[2], b[3]); return w; }
struct EpiIn {
    static constexpr bool PERM = true, AFTER_DRAIN = false;
    unsigned char* ws; float* gates_base;
    __device__ __forceinline__ void operator()(const f32x4 (&acc)[2][2][4][2], const pg8::Unit& u, int wr, int wc, int, int) const {
        EPI_IDX();
        const int row0 = u.pm * 256 + wr * 64 + fr, pn = u.pn;
        bf16 *prw = (bf16*)(ws + WS_PRW), *q = (bf16*)(ws + WS_Q), *k = (bf16*)(ws + WS_K), *vt = (bf16*)(ws + WS_VT), *gates = (bf16*)gates_base;
#pragma unroll
        for (int ai = 0; ai < 2; ++ai)
#pragma unroll
            for (int m = 0; m < 4; ++m) { const int row = row0 + ai * 128 + m * 16;
#pragma unroll
                for (int bj = 0; bj < 2; ++bj) { const int col = pn * 256 + bj * 128 + wc * 32 + 8 * fq; const f32x4 v0 = acc[ai][bj][m][0], v1 = acc[ai][bj][m][1];
                    if (pn < 7) { *(v4u*)(prw + (size_t)row * PRW_LD + col) = pack8(v0, v1); }
                    else if (pn < 13) { const int c2 = col - 1792, which = c2 >> 9, hd = c2 & 511, hh = hd >> 6, d = hd & 63, b = row >> 12, s = row & 4095;
                        if (which < 2) { bf16* dst = (which ? k : q) + ((size_t)((b * NH + hh) * S + s)) * HD + d; *(v4u*)dst = pack8(v0, v1); }
                        else { bf16* dst = vt + ((size_t)((b * NH + hh) * HD + d)) * S + s;
#pragma unroll
                            for (int e = 0; e < 4; ++e) { dst[(size_t)e * S] = (bf16)f2bf(v0[e]); dst[(size_t)(e + 4) * S] = (bf16)f2bf(v1[e]); } } }
                    else if (pn < 21) { *(v4u*)(gates + (size_t)row * 2048 + (col - 3328)) = pack8(v0, v1); }
                    else { if (col < 5408) *(v4u*)(prw + (size_t)row * PRW_LD + 1792 + (col - 5376)) = pack8(v0, v1); } }
                EPI_FENCE(); }
    }
};
__device__ __forceinline__ f32x4 unpack4(const v2u q) { return (f32x4){bflo(q.x), bfhi(q.x), bflo(q.y), bfhi(q.y)}; }
__device__ __forceinline__ v2u pack4(const f32x4 a) { v2u w; w.x = pk2(a[0], a[1]); w.y = pk2(a[2], a[3]); return w; }
template <int GRPT> struct EpiLora {
    static constexpr bool PERM = true, AFTER_DRAIN = false;
    CArgs a; int l;
    template <int GRP> __device__ __forceinline__ void run(const f32x4 (&acc)[2][2][4][2], const pg8::Unit& u, int wr, int wc, int, int) const {
        EPI_IDX();
        const int row0 = u.pm * 256 + wr * 64 + fr;
        unsigned char* ws = a->ws;
        bf16 *km = (bf16*)(ws + WS_KM), *kk = (bf16*)(ws + WS_KK), *vv = (bf16*)(ws + WS_VV), *wl2 = (bf16*)(ws + WS_WL2), *bb = (bf16*)(ws + WS_BB), *gg = (bf16*)(ws + WS_GG); const bf16* vfirst = (const bf16*)(ws + WS_VFIRST);
        const float* pv = GRP == 0 ? a->in[11] + l * 512 : (GRP == 1 ? a->in[13] + l * 512 : a->in[21] + (l > 0 ? (l - 1) * 512 : 0));
        const float* ka = a->in[17] + l * 512;
#pragma unroll
        for (int bj = 0; bj < 2; ++bj)
#pragma unroll
            for (int n = 0; n < 2; ++n) { const int ch = (u.pn & 1) * 256 + bj * 128 + wc * 32 + 8 * fq + 4 * n;
                f32x4 c0 = (f32x4){0.f, 0.f, 0.f, 0.f}, ka0 = c0;
                if (GRP != 2) c0 = *(const f32x4*)(pv + ch);
                if (GRP == 1) ka0 = *(const f32x4*)(ka + ch);
#pragma unroll
                for (int ai = 0; ai < 2; ++ai)
#pragma unroll
                    for (int m = 0; m < 4; ++m) { const size_t off = (size_t)(row0 + ai * 128 + m * 16) * RW + ch; f32x4 x0 = acc[ai][bj][m][n] + c0;
                        if (GRP == 0) {
#pragma unroll
                            for (int e = 0; e < 4; ++e) { const float p = -x0[e]; const float sp = fmaxf(p, 0.f) + flog(1.f + fexp(-fabsf(p))); x0[e] = -fexp(-sp - 0.5f) * LOG2E; }
                            *(v2u*)(wl2 + off) = pack4(x0);
                        } else if (GRP == 1) { f32x4 k0 = unpack4(*(const v2u*)(km + off)), n0 = unpack4(*(const v2u*)(kk + off));
#pragma unroll
                            for (int e = 0; e < 4; ++e) { const float s0 = sigmoidf_(x0[e]); k0[e] = k0[e] * (1.f + (s0 - 1.f) * ka0[e]); n0[e] *= s0; }
                            *(v2u*)(km + off) = pack4(k0); *(v2u*)(bb + off) = pack4(n0);
                        } else if (GRP == 2) { *(v2u*)(gg + off) = pack4(x0);
                        } else { f32x4 a0_ = unpack4(*(const v2u*)(vv + off)); const f32x4 f0 = unpack4(*(const v2u*)(vfirst + off));
#pragma unroll
                            for (int e = 0; e < 4; ++e) a0_[e] += (f0[e] - a0_[e]) * sigmoidf_(x0[e]);
                            *(v2u*)(vv + off) = pack4(a0_); }
                        EPI_FENCE(); } }
    }
    __device__ __forceinline__ void operator()(const f32x4 (&acc)[2][2][4][2], const pg8::Unit& u, int wr, int wc, int, int) const { run<GRPT>(acc, u, wr, wc, 0, 0); }
};
struct EpiNull {
    static constexpr bool PERM = false, AFTER_DRAIN = false;
    float* sink;
    __device__ __forceinline__ void operator()(const f32x4 (&acc)[2][2][4][2], const pg8::Unit& u, int wr, int wc, int, int) const {
        float s = 0.f;
#pragma unroll
        for (int ai = 0; ai < 2; ++ai)
#pragma unroll
            for (int bj = 0; bj < 2; ++bj)
#pragma unroll
                for (int m = 0; m < 4; ++m)
#pragma unroll
                    for (int n = 0; n < 2; ++n) s += acc[ai][bj][m][n][0] + acc[ai][bj][m][n][1] + acc[ai][bj][m][n][2] + acc[ai][bj][m][n][3];
        if (s == 12345.678f) sink[0] = s;
    }
};
struct OffOrder {
    pg8::StaticOrder b; int off;
    __device__ bool next(int i, pg8::Unit& u) const { if (!b.next(i, u)) return false; u.pn += off; return true; }
    __device__ __forceinline__ void a_ready(const pg8::Unit&) const {}
    __device__ __forceinline__ void done(const pg8::Unit&) const {}
};
__device__ __forceinline__ void unpack8(const v4u q, float* x);
__device__ __forceinline__ v4u packarr(const float* x);
template <int SECOND> struct EpiUp {
    static constexpr bool PERM = true, AFTER_DRAIN = false;
    unsigned char* ws; const float* gates_base;
    __device__ __forceinline__ void operator()(const f32x4 (&acc)[2][2][4][2], const pg8::Unit& u, int wr, int wc, int, int) const {
        EPI_IDX();
        const int row0 = u.pm * 256 + wr * 64 + fr;
        const bf16* gates = (const bf16*)gates_base; bf16* merged = (bf16*)(ws + WS_MERGED);
#pragma unroll
        for (int ai = 0; ai < 2; ++ai)
#pragma unroll
            for (int m = 0; m < 4; ++m) { const int row = row0 + ai * 128 + m * 16;
#pragma unroll
                for (int bj = 0; bj < 2; ++bj) { const int col = u.pn * 256 + bj * 128 + wc * 32 + 8 * fq;
                    float g[8]; unpack8(*(const v4u*)(gates + (size_t)row * 2048 + SECOND * 1024 + col), g);
                    bf16* mp = merged + (size_t)row * D + col;
                    float o[8];
#pragma unroll
                    for (int e = 0; e < 4; ++e) { o[e] = sigmoidf_(g[e]) * acc[ai][bj][m][0][e]; o[e + 4] = sigmoidf_(g[e + 4]) * acc[ai][bj][m][1][e]; }
                    if (SECOND == 1) { float p[8]; unpack8(*(const v4u*)mp, p);
#pragma unroll
                        for (int e = 0; e < 8; ++e) o[e] += p[e]; }
                    *(v4u*)mp = packarr(o); }
                EPI_FENCE(); }
    }
};

__device__ __forceinline__ void phase_mod(CArgs a, LAS unsigned char* lds, int tid, int bid, int G) {
    LAS float* sc = (LAS float*)lds;
    LAS float* red = (LAS float*)(lds + 32768);
    float* mod = (float*)(a->ws + WS_MOD);
    const float* c = a->in[1];
    bool loaded = false;
    for (int it = bid; it < 144; it += G) {
        if (!loaded) { for (int i = tid; i < 8192; i += 512) { const int b = i >> 10, k = i & 1023; const float v = c[i]; sc[k * 8 + b] = v * sigmoidf_(v); } loaded = true; }
        __syncthreads();
        const int l = it / 36, j0 = (it % 36) * 256, ln = tid & 63, kq = tid >> 6;
        const float* w = a->in[2] + (size_t)l * 1024 * 9216 + j0 + 4 * ln;
        f32x4 a0[4], a1[4];
#pragma unroll
        for (int q = 0; q < 4; ++q) { a0[q] = (f32x4){0.f, 0.f, 0.f, 0.f}; a1[q] = a0[q]; }
#pragma unroll 8
        for (int k = kq * 128; k < kq * 128 + 128; ++k) { const f32x4 wv = *(const f32x4*)(w + (size_t)k * 9216); const f32x4 s0 = *(LAS const f32x4*)(sc + k * 8), s1 = *(LAS const f32x4*)(sc + k * 8 + 4);
#pragma unroll
            for (int q = 0; q < 4; ++q) { a0[q] += wv[q] * s0; a1[q] += wv[q] * s1; } }
#pragma unroll
        for (int q = 0; q < 4; ++q) { *(LAS f32x4*)(red + ((kq * 256 + 4 * ln + q) * 8)) = a0[q]; *(LAS f32x4*)(red + ((kq * 256 + 4 * ln + q) * 8) + 4) = a1[q]; }
        __syncthreads();
        for (int o = tid; o < 2048; o += 512) { const int cc = o >> 3, bq = o & 7; float sum = 0.f;
#pragma unroll
            for (int q = 0; q < 8; ++q) sum += red[(q * 256 + cc) * 8 + bq];
            mod[(size_t)(l * 8 + bq) * 9216 + j0 + cc] = sum + a->in[3][l * 9216 + j0 + cc]; }
        __syncthreads();
    }
}
template <int MAP> __device__ __forceinline__ void tr_item(const float* W, int K, int N, bf16* WT, LAS float* scr, int item, int lane) {
    const int nblk = N / 32, kb = item / nblk, nb = item % nblk, k0 = 64 * kb, n0 = 32 * nb;
    {
        const int nq = (lane & 7) * 4;
#pragma unroll
        for (int i = 0; i < 8; ++i) { const int kk = 8 * i + (lane >> 3); const f32x4 w4 = *(const f32x4*)(W + (size_t)(k0 + kk) * N + n0 + nq);
            LAS float* d = scr + kk * 33 + nq; d[0] = w4.x; d[1] = w4.y; d[2] = w4.z; d[3] = w4.w; } }
    LDS_WAIT();
    const int c = lane & 7;
#pragma unroll
    for (int j = 0; j < 4; ++j) { const int n = (lane >> 3) + 8 * j; const LAS float* s = scr + (8 * c) * 33 + n;
        v4u o; o.x = pk2(s[0 * 33], s[1 * 33]); o.y = pk2(s[2 * 33], s[3 * 33]); o.z = pk2(s[4 * 33], s[5 * 33]); o.w = pk2(s[6 * 33], s[7 * 33]);
        const int nn = n0 + n; const int dr = MAP == 0 ? nn : ((nn >> 7) * 256 + (MAP == 2 ? 128 : 0) + (nn & 127));
        *(v4u*)(WT + (size_t)dr * K + k0 + 8 * c) = o; }
    LDS_WAIT();
}
__device__ __forceinline__ void phase_convert(CArgs a, LAS unsigned char* lds, int l, int gw, int NGW, int wave, int lane, int gtid, int GT) {
    LAS float* scr = (LAS float*)(lds + wave * 16384);
    unsigned char* ws = a->ws;
    const size_t fo = (size_t)l * 1024 * FF;
    const int nin = l == 0 ? 5376 : 5408;
    const float* win = l == 0 ? a->in[8] : a->in[9] + (size_t)(l - 1) * 1024 * 5408;
    const int I_F = 1408, I_IN = 16 * (nin / 32), I_UP = 256, I_OUT = 512;
    const int total = 6 * I_F + I_IN + 2 * I_UP + I_OUT;
    for (int it = gw; it < total; it += NGW) {
        int r = it;
        if (r < I_F) { tr_item<1>(a->in[5] + fo, 1024, FF, (bf16*)(ws + WS_WG1), scr, r, lane); continue; } r -= I_F;
        if (r < I_F) { tr_item<2>(a->in[6] + fo, 1024, FF, (bf16*)(ws + WS_WG1), scr, r, lane); continue; } r -= I_F;
        if (r < I_F) { tr_item<0>(a->in[7] + fo, FF, 1024, (bf16*)(ws + WS_WG2), scr, r, lane); continue; } r -= I_F;
        if (r < I_F) { tr_item<1>(a->in[28] + fo, 1024, FF, (bf16*)(ws + WS_WG1B), scr, r, lane); continue; } r -= I_F;
        if (r < I_F) { tr_item<2>(a->in[29] + fo, 1024, FF, (bf16*)(ws + WS_WG1B), scr, r, lane); continue; } r -= I_F;
        if (r < I_F) { tr_item<0>(a->in[30] + fo, FF, 1024, (bf16*)(ws + WS_WG2B), scr, r, lane); continue; } r -= I_F;
        if (r < I_IN) { tr_item<0>(win, 1024, nin, (bf16*)(ws + WS_WIN), scr, r, lane); continue; } r -= I_IN;
        if (r < I_UP) { tr_item<0>(a->in[25] + (size_t)l * 512 * 1024, 512, 1024, (bf16*)(ws + WS_WUPA), scr, r, lane); continue; } r -= I_UP;
        if (r < I_UP) { tr_item<0>(a->in[26] + (size_t)l * 512 * 1024, 512, 1024, (bf16*)(ws + WS_WUPB), scr, r, lane); continue; } r -= I_UP;
        tr_item<0>(a->in[27] + (size_t)l * 1024 * 1024, 1024, 1024, (bf16*)(ws + WS_WOUT), scr, r, lane);
    }
    bf16* wl = (bf16*)(ws + WS_WLORA);
    for (int ci = gtid; ci < 2048 * 48; ci += GT) { const int n = ci / 48, kc = ci % 48, grp = n >> 9, ch = n & 511; float v[8];
#pragma unroll
        for (int e = 0; e < 8; ++e) { const int kk = kc * 8 + e; float x = 0.f;
            if (grp == 0) { if (kk < 64) x = a->in[12][((size_t)l * 64 + kk) * 512 + ch]; }
            else if (grp == 1) { if (kk >= 64 && kk < 128) x = a->in[14][((size_t)l * 64 + (kk - 64)) * 512 + ch]; }
            else if (grp == 2) { if (kk >= 128 && kk < 256) x = a->in[15][((size_t)l * 128 + (kk - 128)) * 512 + ch]; }
            else { if (l > 0 && kk >= 256 && kk < 288) x = a->in[22][((size_t)(l - 1) * 32 + (kk - 256)) * 512 + ch]; }
            v[e] = x; }
        v4u o; o.x = pk2(v[0], v[1]); o.y = pk2(v[2], v[3]); o.z = pk2(v[4], v[5]); o.w = pk2(v[6], v[7]);
        *(v4u*)(wl + (size_t)n * 384 + kc * 8) = o; }
}
__device__ __forceinline__ void phase_norm(const float* x32, const bf16* h16, const float* g, const float* modl, int i3, bf16* nout, int gw, int NGW, int lane) {
#pragma unroll 2
    for (int m = gw; m < M; m += NGW) { const int b = m >> 12; const float* sh = modl + (size_t)b * 9216 + (3 * i3) * 1024; const float* sc = sh + 1024;
        float v[2][8]; float ss = 0.f;
#pragma unroll
        for (int j = 0; j < 2; ++j) { const int col = 8 * lane + 512 * j;
            if (x32) { const f32x4 a0 = *(const f32x4*)(x32 + (size_t)m * D + col), a1 = *(const f32x4*)(x32 + (size_t)m * D + col + 4);
#pragma unroll
                for (int e = 0; e < 4; ++e) { v[j][e] = a0[e]; v[j][e + 4] = a1[e]; } }
            else unpack8(*(const v4u*)(h16 + (size_t)m * D + col), v[j]);
#pragma unroll
            for (int e = 0; e < 8; ++e) ss += v[j][e] * v[j][e]; }
        const float rstd = __builtin_amdgcn_rsqf(wave_sum(ss, lane) * (1.f / D) + 1e-6f);
#pragma unroll
        for (int j = 0; j < 2; ++j) { const int col = 8 * lane + 512 * j; float y[8];
            const f32x4 g0 = *(const f32x4*)(g + col), g1 = *(const f32x4*)(g + col + 4), s0 = *(const f32x4*)(sc + col), s1 = *(const f32x4*)(sc + col + 4), h0 = *(const f32x4*)(sh + col), h1 = *(const f32x4*)(sh + col + 4);
#pragma unroll
            for (int e = 0; e < 4; ++e) { y[e] = v[j][e] * rstd * g0[e] * (1.f + s0[e]) + h0[e]; y[e + 4] = v[j][e + 4] * rstd * g1[e] * (1.f + s1[e]) + h1[e]; }
            *(v4u*)(nout + (size_t)m * D + col) = packarr(y); } }
}
__device__ __forceinline__ void unpack8(const v4u q, float* x) { x[0] = bflo(q.x); x[1] = bfhi(q.x); x[2] = bflo(q.y); x[3] = bfhi(q.y); x[4] = bflo(q.z); x[5] = bfhi(q.z); x[6] = bflo(q.w); x[7] = bfhi(q.w); }
__device__ __forceinline__ v4u packarr(const float* x) { v4u o; o.x = pk2(x[0], x[1]); o.y = pk2(x[2], x[3]); o.z = pk2(x[4], x[5]); o.w = pk2(x[6], x[7]); return o; }
__device__ __forceinline__ void phase_prep(CArgs a, int l, int gw, int NGW, int lane, const bool do_qk = true) {
    unsigned char* ws = a->ws;
    const bf16* prw = (const bf16*)(ws + WS_PRW);
    bf16 *R = (bf16*)(ws + WS_R), *KM = (bf16*)(ws + WS_KM), *KK = (bf16*)(ws + WS_KK), *VV = (bf16*)(ws + WS_VV), *VF = (bf16*)(ws + WS_VFIRST), *AL = (bf16*)(ws + WS_ALORA);
    const float* mu = a->in[10] + (size_t)l * 1792; const float* kkw = a->in[16] + (size_t)l * 512;
    const v4u z4 = (v4u){0u, 0u, 0u, 0u};
#pragma unroll 2
    for (int m = gw; m < M; m += NGW) { const int s = m & 4095, b = m >> 12; const bool hp = s != 0;
        const bf16* cur = prw + (size_t)m * PRW_LD; const bf16* prv = cur - PRW_LD;
#pragma unroll
        for (int i = 0; i < 3; ++i) { const int col = (lane + 64 * i) * 8; float c[8], p[8], x[8];
            unpack8(*(const v4u*)(cur + col), c); unpack8(hp ? *(const v4u*)(prv + col) : z4, p);
            const f32x4 m0 = *(const f32x4*)(mu + col), m1 = *(const f32x4*)(mu + col + 4);
#pragma unroll
            for (int e = 0; e < 4; ++e) { x[e] = c[e] + (p[e] - c[e]) * m0[e]; x[e + 4] = c[e + 4] + (p[e + 4] - c[e + 4]) * m1[e]; }
            const size_t off = (size_t)m * RW + lane * 8;
            if (i == 0) *(v4u*)(R + off) = packarr(x);
            else if (i == 1) { *(v4u*)(KM + off) = packarr(x); const f32x4 k0 = *(const f32x4*)(kkw + lane * 8), k1 = *(const f32x4*)(kkw + lane * 8 + 4); float ss = 0.f;
#pragma unroll
                for (int e = 0; e < 4; ++e) { x[e] *= k0[e]; x[e + 4] *= k1[e]; ss += x[e] * x[e] + x[e + 4] * x[e + 4]; }
                ss += SHX(ss, 1); ss += SHX(ss, 2); ss += SHX(ss, 4);
                const float inv = fminf(__builtin_amdgcn_rsqf(ss), 1e12f);
#pragma unroll
                for (int e = 0; e < 8; ++e) x[e] *= inv;
                *(v4u*)(KK + off) = packarr(x); }
            else { const v4u o = packarr(x); *(v4u*)(VV + off) = o; if (l == 0) *(v4u*)(VF + off) = o; } }
        if (lane < 48) { float x[8];
            if (lane < 32) { const int col = 1536 + lane * 8; float c[8], p[8];
                unpack8(*(const v4u*)(cur + col), c); unpack8(hp ? *(const v4u*)(prv + col) : z4, p);
#pragma unroll
                for (int e = 0; e < 8; ++e) { const float xx = c[e] + (p[e] - c[e]) * mu[col + e];
                    x[e] = lane < 8 ? (1.f - 2.f * __builtin_amdgcn_rcpf(fexp(2.f * xx) + 1.f)) : (lane < 16 ? xx : sigmoidf_(xx)); } }
            else if (lane < 36 && l > 0) { unpack8(*(const v4u*)(cur + 1792 + (lane - 32) * 8), x); }
            else {
#pragma unroll
                for (int e = 0; e < 8; ++e) x[e] = 0.f; }
            *(v4u*)(AL + (size_t)m * 384 + lane * 8) = packarr(x); }
    }
}
constexpr int SC_T = 32, SC_NP = 16, SC_VEC = 0, SC_SCAL = 9216, SC_V = 9280, SC_BUFF = 9792, SC_BUF = SC_BUFF * 4, SC_YB = 2 * SC_BUF;
__device__ __forceinline__ f32x4 h4(const v2u q) { return (f32x4){bflo(q.x), bfhi(q.x), bflo(q.y), bfhi(q.y)}; }
__device__ __forceinline__ float dot4(const f32x4 a, const f32x4 b) { f32x2 t = (f32x2){a.x, a.y} * (f32x2){b.x, b.y}; t = (f32x2){a.z, a.w} * (f32x2){b.z, b.w} + t; return t.x + t.y; }
__device__ __forceinline__ void scan_unit(CArgs a, LAS unsigned char* lds, int l, int hh, int qq, int tid) {
    unsigned char* ws = a->ws;
    const int b = hh >> 3, h = hh & 7;
    constexpr int NC = S / SC_T;
    if (tid >= 256) {
        const int ht = tid - 256, hp = ht >> 4, hl = ht & 15;
        const size_t goff = ((size_t)b * S + 2 * hp) * RW + h * 64 + hl * 4;
        const bf16 *t0 = (const bf16*)(ws + WS_R) + goff, *t1 = (const bf16*)(ws + WS_WL2) + goff, *t2 = (const bf16*)(ws + WS_KM) + goff, *t3 = (const bf16*)(ws + WS_KK) + goff, *t4 = (const bf16*)(ws + WS_BB) + goff;
        const bf16* t5 = (const bf16*)(ws + WS_VV) + ((size_t)b * S + (ht >> 1)) * RW + h * 64 + 16 * qq + (ht & 1) * 8;
        const int ytok = ht >> 3, ypart = ht & 7;
        bf16* yo = (bf16*)(ws + WS_YA) + ((size_t)b * S + ytok) * RW + h * 64 + 16 * qq + 2 * ypart;
        v2u r0q, r1q, w0q, w1q, k0q, k1q, n0q, n1q, b0q, b1q; v4u vq = (v4u){0u, 0u, 0u, 0u};
#define SC_HLOAD(cc) { const size_t o2 = (size_t)(cc) * SC_T * RW; r0q = *(const v2u*)(t0 + o2); r1q = *(const v2u*)(t0 + o2 + RW); w0q = *(const v2u*)(t1 + o2); w1q = *(const v2u*)(t1 + o2 + RW); \
            k0q = *(const v2u*)(t2 + o2); k1q = *(const v2u*)(t2 + o2 + RW); n0q = *(const v2u*)(t3 + o2); n1q = *(const v2u*)(t3 + o2 + RW); b0q = *(const v2u*)(t4 + o2); b1q = *(const v2u*)(t4 + o2 + RW); \
            if (ht < 64) vq = *(const v4u*)(t5 + o2); }
#define SC_HSTORE(cc) { LAS float* B = (LAS float*)(lds + ((cc) & 1) * SC_BUF); LAS float* vb = B + (hp * 9) * 64 + hl * 4; \
            const f32x4 r0 = h4(r0q), r1 = h4(r1q), k0 = h4(k0q), k1 = h4(k1q), n0 = h4(n0q), n1 = h4(n1q), b0 = h4(b0q), b1 = h4(b1q); f32x4 w0 = h4(w0q), w1 = h4(w1q); \
            _Pragma("unroll") for (int e = 0; e < 4; ++e) { w0[e] = __builtin_amdgcn_exp2f(w0[e]); w1[e] = __builtin_amdgcn_exp2f(w1[e]); } \
            *(LAS f32x4*)(vb) = n0; *(LAS f32x4*)(vb + 64) = w0 * n1; *(LAS f32x4*)(vb + 128) = w0 * w1; *(LAS f32x4*)(vb + 192) = b0 * w1; *(LAS f32x4*)(vb + 256) = k0 * w1; \
            *(LAS f32x4*)(vb + 320) = b1; *(LAS f32x4*)(vb + 384) = k1; *(LAS f32x4*)(vb + 448) = w0 * r0; *(LAS f32x4*)(vb + 512) = r1; \
            const float c1 = -red16(dot4(b0, n1)), c2 = -red16(dot4(k0, n1)), c3 = red16(dot4(b0, r0)), c4 = red16(dot4(k0, r0)); \
            if (hl == 0) *(LAS f32x4*)(B + SC_SCAL + hp * 4) = (f32x4){c1, c2, c3, c4}; \
            if (ht < 64) { float x[8]; unpack8(vq, x); const int vt = ht >> 1; LAS float* d = B + SC_V + ((vt >> 1) * 16 + (ht & 1) * 8) * 2 + (vt & 1); \
                _Pragma("unroll") for (int e = 0; e < 8; ++e) d[2 * e] = x[e]; } }
#define SC_HBAR() { asm volatile("s_waitcnt lgkmcnt(0)" ::: "memory"); __builtin_amdgcn_s_barrier(); asm volatile("" ::: "memory"); }
        SC_HLOAD(0); SC_HSTORE(0); SC_HLOAD(1);
        SC_HBAR();
        for (int c = 0; c < NC; ++c) {
            if (c + 1 < NC) SC_HSTORE(c + 1);
            if (c + 2 < NC) SC_HLOAD(c + 2);
            if (c >= 1) { LAS const float* yb = (LAS const float*)(lds + SC_YB + ((c - 1) & 1) * 2048) + ytok * 16 + 2 * ypart; *(unsigned*)(yo + (size_t)(c - 1) * SC_T * RW) = pk2(yb[0], yb[1]); }
            SC_HBAR();
        }
#undef SC_HLOAD
#undef SC_HSTORE
#undef SC_HBAR
        { LAS const float* yb = (LAS const float*)(lds + SC_YB + ((NC - 1) & 1) * 2048) + ytok * 16 + 2 * ypart; *(unsigned*)(yo + (size_t)(NC - 1) * SC_T * RW) = pk2(yb[0], yb[1]); }
    } else {
        const int row = tid >> 4, ks = tid & 15;
        f32x4 s0 = (f32x4){0.f, 0.f, 0.f, 0.f};
        __syncthreads();
        for (int c = 0; c < NC; ++c) {
            LAS const float* B0 = (LAS const float*)(lds + (c & 1) * SC_BUF);
            LAS float* yb = (LAS float*)(lds + SC_YB + (c & 1) * 2048);
#define SC_LD(P, j_) { const int jl = (j_) < SC_NP ? (j_) : SC_NP - 1; LAS const float* vb = B0 + (jl * 9) * 64 + 4 * ks; \
                P##0 = *(LAS const f32x4*)(vb); P##1 = *(LAS const f32x4*)(vb + 64); P##2 = *(LAS const f32x4*)(vb + 128); P##3 = *(LAS const f32x4*)(vb + 192); P##4 = *(LAS const f32x4*)(vb + 256); \
                P##5 = *(LAS const f32x4*)(vb + 320); P##6 = *(LAS const f32x4*)(vb + 384); P##7 = *(LAS const f32x4*)(vb + 448); P##8 = *(LAS const f32x4*)(vb + 512); \
                P##c = *(LAS const f32x4*)(B0 + SC_SCAL + jl * 4); P##v = *(LAS const f32x2*)(B0 + SC_V + (jl * 16 + row) * 2); }
#define SC_STEP(P, j_) { const float d0 = red16(dot4(s0, P##0)), e1 = red16(dot4(s0, P##1)), g0 = red16(dot4(s0, P##7)); \
                const float sa0 = -d0, sa1 = (sa0 * P##c.x + P##v.x * P##c.y) - e1, y0 = g0 + (sa0 * P##c.z + P##v.x * P##c.w); \
                s0 = s0 * P##2 + (sa0 * P##3 + P##v.x * P##4) + (sa1 * P##5 + P##v.y * P##6); \
                const float y1 = red16(dot4(s0, P##8)); \
                if (ks == 0) { yb[(2 * (j_)) * 16 + row] = y0; yb[(2 * (j_) + 1) * 16 + row] = y1; } }
            f32x4 A0, A1, A2, A3, A4, A5, A6, A7, A8, Ac, B_0, B_1, B_2, B_3, B_4, B_5, B_6, B_7, B_8, B_c; f32x2 Av, B_v;
            SC_LD(A, 0); SC_LD(B_, 1);
#pragma unroll 2
            for (int j = 0; j < SC_NP; j += 2) {
                SC_STEP(A, j); SC_LD(A, j + 2);
                SC_STEP(B_, j + 1); SC_LD(B_, j + 3);
            }
#undef SC_LD
#undef SC_STEP
            __syncthreads();
        }
    }
    __syncthreads();
}
__device__ __forceinline__ void phase_scanfin(CArgs a, int l, int gw, int NGW, int lane, const bool do_store = true) {
    unsigned char* ws = a->ws;
    bf16* YA = (bf16*)(ws + WS_YA); const bf16 *R = (const bf16*)(ws + WS_R), *KM = (const bf16*)(ws + WS_KM), *VV = (const bf16*)(ws + WS_VV), *GG = (const bf16*)(ws + WS_GG);
    const int ch = lane * 8;
    float lw[8], lb[8], rk[8];
#pragma unroll
    for (int e = 0; e < 8; ++e) { lw[e] = a->in[19][l * 512 + ch + e]; lb[e] = a->in[20][l * 512 + ch + e]; rk[e] = a->in[18][l * 512 + ch + e]; }
#pragma unroll 2
    for (int m = gw; m < M; m += NGW) { const size_t off = (size_t)m * RW + ch; float y[8], r[8], k[8], v[8], g[8];
        unpack8(*(const v4u*)(YA + off), y); unpack8(*(const v4u*)(R + off), r); unpack8(*(const v4u*)(KM + off), k); unpack8(*(const v4u*)(VV + off), v); unpack8(*(const v4u*)(GG + off), g);
        float s1 = 0.f, bs = 0.f;
#pragma unroll
        for (int e = 0; e < 8; ++e) { s1 += y[e]; bs += r[e] * k[e] * rk[e]; }
        s1 += SHX(s1, 1); s1 += SHX(s1, 2); s1 += SHX(s1, 4); bs += SHX(bs, 1); bs += SHX(bs, 2); bs += SHX(bs, 4);
        const float mean = s1 * (1.f / 64.f); float s2 = 0.f;
#pragma unroll
        for (int e = 0; e < 8; ++e) { y[e] -= mean; s2 += y[e] * y[e]; }
        s2 += SHX(s2, 1); s2 += SHX(s2, 2); s2 += SHX(s2, 4);
        const float rstd = __builtin_amdgcn_rsqf(s2 * (1.f / 64.f) + 64e-5f);
#pragma unroll
        for (int e = 0; e < 8; ++e) y[e] = (y[e] * rstd * lw[e] + lb[e] + bs * v[e]) * g[e];
        if (do_store || y[0] == 12345.678f) *(v4u*)(YA + off) = packarr(y); }
}
constexpr int AT_BUF = 18432, AT_LDK = 72;
constexpr float AT_EXIT = 64.f;
__device__ __forceinline__ float softplus2(float z) { return fmaxf(z, 0.f) + __builtin_amdgcn_logf(1.f + __builtin_amdgcn_exp2f(-fabsf(z))); }
__device__ __forceinline__ void attn_unit(CArgs a, LAS unsigned char* lds, int l, int bh, int qb, int tid, int wave, int lane) {
    unsigned char* ws = a->ws;
    const bf16* Q = (const bf16*)(ws + WS_Q) + (size_t)bh * S * HD; const bf16* K = (const bf16*)(ws + WS_K) + (size_t)bh * S * HD; const bf16* VT = (const bf16*)(ws + WS_VT) + (size_t)bh * HD * S;
    bf16* YB = (bf16*)(ws + WS_YB);
    const int ql = lane & 31, hi = lane >> 5, qr0 = qb * 256 + wave * 32, qabs = qr0 + ql;
    bf16x8 qf[4];
    {
        const float* qg = a->in[23] + l * 64; float xq[4][8]; float ss = 0.f;
#pragma unroll
        for (int ds = 0; ds < 4; ++ds) { unpack8(*(const v4u*)(Q + (size_t)qabs * HD + 16 * ds + 8 * hi), xq[ds]);
#pragma unroll
            for (int e = 0; e < 8; ++e) ss += xq[ds][e] * xq[ds][e]; }
        const auto rr = __builtin_amdgcn_permlane32_swap(__float_as_uint(ss), __float_as_uint(ss), false, false);
        const float rstd = __builtin_amdgcn_rsqf((__uint_as_float(rr[0]) + __uint_as_float(rr[1])) * (1.f / 64.f) + 1e-6f) * (0.125f * LOG2E);
#pragma unroll
        for (int ds = 0; ds < 4; ++ds) {
#pragma unroll
            for (int e = 0; e < 8; ++e) xq[ds][e] *= rstd * qg[16 * ds + 8 * hi + e];
            qf[ds] = __builtin_bit_cast(bf16x8, packarr(xq[ds])); } }
    f32x16 o0, o1;
#pragma unroll
    for (int r = 0; r < 16; ++r) { o0[r] = 0.f; o1[r] = 0.f; }
    float L = 0.f; float wmin = 0.f;
    const int srow = tid >> 3, spart = tid & 7;
    const f32x4 kg0 = *(const f32x4*)(a->in[24] + l * 64 + spart * 8), kg1 = *(const f32x4*)(a->in[24] + l * 64 + spart * 8 + 4);
#define AT_KNORM(kq_) { float xk[8]; unpack8(kq_, xk); float ss = 0.f; _Pragma("unroll") for (int e = 0; e < 8; ++e) ss += xk[e] * xk[e]; \
        ss += SHX(ss, 1); ss += SHX(ss, 2); ss += SHX(ss, 4); const float rs_ = __builtin_amdgcn_rsqf(ss * (1.f / 64.f) + 1e-6f); \
        _Pragma("unroll") for (int e = 0; e < 4; ++e) { xk[e] *= rs_ * kg0[e]; xk[e + 4] *= rs_ * kg1[e]; } kq_ = packarr(xk); }
    LAS float* lmin = (LAS float*)(lds + MISC_OFF + 64);
    int kt = qb * 4 + 3;
    v4u kq = *(const v4u*)(K + (size_t)(64 * kt + srow) * HD + spart * 8), vq = *(const v4u*)(VT + (size_t)srow * S + 64 * kt + spart * 8);
    AT_KNORM(kq);
    *(LAS v4u*)(lds + srow * (AT_LDK * 2) + spart * 16) = kq; *(LAS v4u*)(lds + 9216 + srow * (AT_LDK * 2) + spart * 16) = vq;
    __syncthreads();
    int cur = 0;
    for (; kt >= 0; --kt) {
        if (kt > 0) { kq = *(const v4u*)(K + (size_t)(64 * (kt - 1) + srow) * HD + spart * 8); vq = *(const v4u*)(VT + (size_t)srow * S + 64 * (kt - 1) + spart * 8); }
        LAS const unsigned char* Ks = lds + cur * AT_BUF; LAS const unsigned char* Vs = Ks + 9216;
        if (64 * kt < qr0 + 31 && wmin <= AT_EXIT) {
            f32x16 p0, p1;
#pragma unroll
            for (int r = 0; r < 16; ++r) { p0[r] = 0.f; p1[r] = 0.f; }
#pragma unroll
            for (int ds = 0; ds < 4; ++ds) { const bf16x8 k0 = *(LAS const bf16x8*)(Ks + ql * (AT_LDK * 2) + ds * 32 + hi * 16), k1 = *(LAS const bf16x8*)(Ks + (32 + ql) * (AT_LDK * 2) + ds * 32 + hi * 16);
                p0 = __builtin_amdgcn_mfma_f32_32x32x16_f16(__builtin_bit_cast(h16x8, k0), __builtin_bit_cast(h16x8, qf[ds]), p0, 0, 0, 0); p1 = __builtin_amdgcn_mfma_f32_32x32x16_f16(__builtin_bit_cast(h16x8, k1), __builtin_bit_cast(h16x8, qf[ds]), p1, 0, 0, 0); }
            const bool need_mask = (64 * kt + 63 >= qr0);
            f32x16 sp0, sp1;
#pragma unroll
            for (int r = 0; r < 16; ++r) { const int kl = (r & 3) + 8 * (r >> 2) + 4 * hi; float a0 = softplus2(p0[r]), a1 = softplus2(p1[r]);
                p0[r] -= a0; p1[r] -= a1;
                if (need_mask) { if (64 * kt + kl >= qabs) { a0 = 0.f; p0[r] = -1e30f; } if (64 * kt + 32 + kl >= qabs) { a1 = 0.f; p1[r] = -1e30f; } }
                sp0[r] = a0; sp1[r] = a1; }
            float off[8]; float run = 0.f;
#pragma unroll
            for (int g = 7; g >= 0; --g) { const float gs = g < 4 ? (sp0[4 * g] + sp0[4 * g + 1]) + (sp0[4 * g + 2] + sp0[4 * g + 3]) : (sp1[4 * g - 16] + sp1[4 * g - 15]) + (sp1[4 * g - 14] + sp1[4 * g - 13]);
                const auto rr = __builtin_amdgcn_permlane32_swap(__float_as_uint(gs), __float_as_uint(gs), false, false);
                const float x0 = __uint_as_float(rr[0]), x1 = __uint_as_float(rr[1]);
                off[g] = run + (hi ? 0.f : x1);
                run += x0 + x1; }
            bf16x8 pf[4];
#pragma unroll
            for (int g = 0; g < 8; ++g) { float e3, e2, e1, e0;
                if (g < 4) { e3 = off[g] + L; e2 = e3 + sp0[4 * g + 3]; e1 = e2 + sp0[4 * g + 2]; e0 = e1 + sp0[4 * g + 1];
                    const float w0 = __builtin_amdgcn_exp2f(p0[4 * g] - e0), w1 = __builtin_amdgcn_exp2f(p0[4 * g + 1] - e1), w2 = __builtin_amdgcn_exp2f(p0[4 * g + 2] - e2), w3 = __builtin_amdgcn_exp2f(p0[4 * g + 3] - e3);
                    const unsigned u0 = pk2(w0, w1), u1 = pk2(w2, w3); const int j = g >> 1, e = (g & 1) * 4;
                    pf[j][e] = (short)(u0 & 0xffff); pf[j][e + 1] = (short)(u0 >> 16); pf[j][e + 2] = (short)(u1 & 0xffff); pf[j][e + 3] = (short)(u1 >> 16); }
                else { const int gg = g - 4; e3 = off[g] + L; e2 = e3 + sp1[4 * gg + 3]; e1 = e2 + sp1[4 * gg + 2]; e0 = e1 + sp1[4 * gg + 1];
                    const float w0 = __builtin_amdgcn_exp2f(p1[4 * gg] - e0), w1 = __builtin_amdgcn_exp2f(p1[4 * gg + 1] - e1), w2 = __builtin_amdgcn_exp2f(p1[4 * gg + 2] - e2), w3 = __builtin_amdgcn_exp2f(p1[4 * gg + 3] - e3);
                    const unsigned u0 = pk2(w0, w1), u1 = pk2(w2, w3); const int j = g >> 1, e = (g & 1) * 4;
                    pf[j][e] = (short)(u0 & 0xffff); pf[j][e + 1] = (short)(u0 >> 16); pf[j][e + 2] = (short)(u1 & 0xffff); pf[j][e + 3] = (short)(u1 >> 16); } }
            L += run;
#pragma unroll
            for (int j = 0; j < 4; ++j) {
                const v2u a00 = *(LAS const v2u*)(Vs + ql * (AT_LDK * 2) + (16 * j + 4 * hi) * 2), a01 = *(LAS const v2u*)(Vs + ql * (AT_LDK * 2) + (16 * j + 8 + 4 * hi) * 2);
                const v2u a10 = *(LAS const v2u*)(Vs + (32 + ql) * (AT_LDK * 2) + (16 * j + 4 * hi) * 2), a11 = *(LAS const v2u*)(Vs + (32 + ql) * (AT_LDK * 2) + (16 * j + 8 + 4 * hi) * 2);
                const v4u A0 = (v4u){a00.x, a00.y, a01.x, a01.y}, A1 = (v4u){a10.x, a10.y, a11.x, a11.y};
                o0 = __builtin_amdgcn_mfma_f32_32x32x16_f16(__builtin_bit_cast(h16x8, A0), __builtin_bit_cast(h16x8, pf[j]), o0, 0, 0, 0);
                o1 = __builtin_amdgcn_mfma_f32_32x32x16_f16(__builtin_bit_cast(h16x8, A1), __builtin_bit_cast(h16x8, pf[j]), o1, 0, 0, 0); }
        }
        float wm = L;
#pragma unroll
        for (int o = 1; o < 64; o <<= 1) wm = fminf(wm, SHX(wm, o));
        wmin = wm;
        if (lane == 0) lmin[wave] = wm;
        __syncthreads();
        float bm = lmin[0];
#pragma unroll
        for (int w = 1; w < 8; ++w) bm = fminf(bm, lmin[w]);
        if (bm > AT_EXIT || kt == 0) break;
        cur ^= 1;
        AT_KNORM(kq);
        *(LAS v4u*)(lds + cur * AT_BUF + srow * (AT_LDK * 2) + spart * 16) = kq; *(LAS v4u*)(lds + cur * AT_BUF + 9216 + srow * (AT_LDK * 2) + spart * 16) = vq;
        __syncthreads();
    }
    const int b = bh >> 3, h = bh & 7;
    bf16* yrow = YB + ((size_t)b * S + qabs) * RW + h * 64;
#pragma unroll
    for (int g = 0; g < 4; ++g) { v2u w; w.x = pk2(o0[4 * g], o0[4 * g + 1]); w.y = pk2(o0[4 * g + 2], o0[4 * g + 3]); *(v2u*)(yrow + 8 * g + 4 * hi) = w;
        w.x = pk2(o1[4 * g], o1[4 * g + 1]); w.y = pk2(o1[4 * g + 2], o1[4 * g + 3]); *(v2u*)(yrow + 32 + 8 * g + 4 * hi) = w; }
    __syncthreads();
}
__device__ __forceinline__ void phase_mixer(CArgs a, LAS unsigned char* lds, int l, const int wave_s) {
    unsigned* ctr = (unsigned*)(a->ws + WS_CTL) + 64 * l; l &= 3;
    volatile LAS unsigned* qw = (volatile LAS unsigned*)(lds + MISC_OFF);
#ifdef PROBE_ATT2
    constexpr int NU = 256 + 2 * 64 * 16;
#else
    constexpr int NU = 256 + 64 * 16;
#endif
    for (;;) {
        const int lane = fresh_lane(), wave = wave_s, tid = wave * 64 + lane;
        if (tid == 0) qw[0] = atomicAdd(ctr, 1u);
        __syncthreads();
        const int u = (int)qw[0];
        __syncthreads();
        if (u >= NU) break;
        if (u < 256) scan_unit(a, lds, l, u >> 2, u & 3, tid);
        else { const int v = (u - 256) & 1023; attn_unit(a, lds, l, v & 63, 15 - (v >> 6), tid, wave, lane); }
    }
}
#define XB_TMO      128
#define XB_XCNT(j)  (256  + 64 * (j))
#define XB_XSUB(j)  (1280 + 64 * (j))
#define XB_XGEN(j)  (2304 + 64 * (j))
#define XB_TOP      3328
#define XB_TOPGEN   3392
#define XCD_BAR_WORDS 3456
#define XB_SPIN_CAP (1u << 18)
constexpr int BAR_WORD0 = 16384;
__device__ __forceinline__ unsigned xb_ld(unsigned* p)              { return __hip_atomic_load(p, __ATOMIC_RELAXED, __HIP_MEMORY_SCOPE_AGENT); }
__device__ __forceinline__ unsigned xb_add(unsigned* p, unsigned v) { return __hip_atomic_fetch_add(p, v, __ATOMIC_RELAXED, __HIP_MEMORY_SCOPE_AGENT); }
__device__ __forceinline__ unsigned xb_xcc_id() { return (unsigned)__builtin_amdgcn_s_getreg((3 << 11) | 20) & 0xFu; }
#define XB_SPIN(cond, bar) do { unsigned _sp = 0; while (cond) { __builtin_amdgcn_s_sleep(1); \
    if ((++_sp & 255u) == 0u) { if (xb_ld(&(bar)[XB_TMO])) break; if (_sp > XB_SPIN_CAP) { atomicAdd(&(bar)[XB_TMO], 1u); break; } } } } while (0)
__device__ __forceinline__ void xcd_barrier_complete(unsigned* bar, unsigned x, unsigned& nloc, unsigned& nx) {
    const unsigned G = gridDim.x * gridDim.y * gridDim.z;
    unsigned sum, cnt, mine, sp = 0u;
    for (;;) {
        sum = 0u; cnt = 0u; mine = 0u;
#pragma unroll
        for (unsigned j = 0; j < 16; ++j) { const unsigned c = xb_ld(&bar[XB_XCNT(j)]); sum += c; cnt += (c > 0u) ? 1u : 0u; mine = (j == x) ? c : mine; }
        if (sum == G) break;
        __builtin_amdgcn_s_sleep(1);
        if ((++sp & 255u) == 0u) { if (xb_ld(&bar[XB_TMO])) break; if (sp > XB_SPIN_CAP) { atomicAdd(&bar[XB_TMO], 1u); break; } }
    }
    nloc = mine > 0u ? mine : 1u; nx = cnt > 0u ? cnt : 1u;
}
__device__ __forceinline__ void grid_barrier(unsigned* ctl, LAS unsigned char* lds, const int wave_s) {
    asm volatile("s_waitcnt vmcnt(0) lgkmcnt(0)" ::: "memory");
    __syncthreads();
    if (wave_s * 64 + fresh_lane() == 0) {
        unsigned* bar = ctl + BAR_WORD0; volatile LAS unsigned* st = (volatile LAS unsigned*)(lds + MISC_OFF + 128);
        const unsigned x = xb_xcc_id();
        __builtin_amdgcn_s_waitcnt(0);
        unsigned nloc = st[0], nx = st[1];
        if (nloc == 0u) { xcd_barrier_complete(bar, x, nloc, nx); st[0] = nloc; st[1] = nx; }
        const unsigned old = xb_add(&bar[XB_XSUB(x)], 1u);
        const unsigned gen = old / nloc;
        if (old + 1u == (gen + 1u) * nloc) {
            __builtin_amdgcn_fence(__ATOMIC_RELEASE, "agent");
            asm volatile("s_waitcnt vmcnt(0)" ::: "memory");
            const unsigned og = xb_add(&bar[XB_TOP], 1u);
            const unsigned tg = og / nx;
            if (og + 1u == (tg + 1u) * nx) xb_add(&bar[XB_TOPGEN], 1u);
            else XB_SPIN(xb_ld(&bar[XB_TOPGEN]) == tg, bar);
            __builtin_amdgcn_fence(__ATOMIC_ACQUIRE, "agent");
            xb_add(&bar[XB_XGEN(x)], 1u);
            asm volatile("s_waitcnt vmcnt(0)" ::: "memory");
        } else {
            XB_SPIN(xb_ld(&bar[XB_XGEN(x)]) == gen, bar);
            __builtin_amdgcn_fence(__ATOMIC_ACQUIRE, "agent");
            asm volatile("s_waitcnt vmcnt(0)" ::: "memory");
        }
    }
    __syncthreads();
}
__global__ void __launch_bounds__(512, 2) mk_fwd(Args a) {
    extern __shared__ __attribute__((aligned(16))) unsigned char lds_raw[];
    LAS unsigned char* lds = (LAS unsigned char*)lds_raw;
    cg::grid_group grid = cg::this_grid();
    const int wave_k = __builtin_amdgcn_readfirstlane((int)threadIdx.x >> 6);
    { const int t0 = wave_k * 64 + fresh_lane(); if (t0 < 2) ((volatile LAS unsigned*)(lds + MISC_OFF + 128))[t0] = 0u;
      if (t0 == 0) (void)xb_add((unsigned*)(a.ws + WS_CTL) + BAR_WORD0 + XB_XCNT(xb_xcc_id()), 1u); }
    __syncthreads();
    grid.sync();
    unsigned bar_round = 0;
    const int ph_lo = a.ph_lo, ph_hi = a.ph_hi;
    for (int ph = ph_lo; ph < ph_hi; ++ph) {
        int bid = blockIdx.x; asm volatile("" : "+s"(bid));
        int wave_s = wave_k; asm volatile("" : "+s"(wave_s));
#define FRESH_TID() const int lane = fresh_lane(), wave = wave_s, tid = wave * 64 + lane, gw = bid * 8 + wave; (void)tid; (void)gw
        CArgs ap = (CArgs)__builtin_amdgcn_kernarg_segment_ptr(); asm volatile("" : "+s"(ap));
        const int G = gridDim.x, NGW = G * 8;
        unsigned char* ws = ap->ws;
        const float* mod = (const float*)(ws + WS_MOD);
        if (ph == 0) {
#ifndef SK_MOD
            FRESH_TID(); phase_mod(ap, lds, tid, bid, G);
#ifdef PROBE_THIN2
            __syncthreads(); phase_mod(ap, lds, tid, bid, G);
#endif
#endif
        }
        else {
            const int l = (ph - 1) / NPH_LAYER, idx = (ph - 1) % NPH_LAYER;
            const float* modl = mod + (size_t)l * 8 * 9216;
            if (0) {}
#ifndef SK_NORM
            else if (idx == 0 || idx == 3 || idx == 11) {
                FRESH_TID();
                if (idx == 0) phase_convert(ap, lds, l, gw, NGW, wave, lane, bid * 512 + tid, G * 512);
#ifdef PROBE_CONV2
                if (idx == 0) { __syncthreads(); phase_convert(ap, lds, l, gw, NGW, wave, lane, bid * 512 + tid, G * 512); }
#endif
                const int i3 = idx == 0 ? 0 : (idx == 3 ? 1 : 2);
                phase_norm((l == 0 && idx == 0) ? ap->in[0] : nullptr, (const bf16*)(ws + WS_H16), ap->in[4] + (size_t)(l * 3 + i3) * 1024, modl, i3, (bf16*)(ws + WS_N), gw, NGW, lane);
#ifdef PROBE_NORM2
                phase_norm((l == 0 && idx == 0) ? ap->in[0] : nullptr, (const bf16*)(ws + WS_H16), ap->in[4] + (size_t)(l * 3 + i3) * 1024, modl, i3, (bf16*)(ws + WS_N), gw, NGW, lane);
#endif
            }
#endif
#ifndef SK_G1
            else if (idx == 1 || idx == 12) {
                pg8::Gemm g{(const pg8::bf16_t*)(ws + WS_N), (const pg8::bf16_t*)(ws + (idx == 1 ? WS_WG1 : WS_WG1B)), M, 2 * FF, D}; pg8::StaticOrder So; So.init(M, 2 * FF, G, bid);
                EpiSwiglu E{(bf16*)(ws + WS_ACT)};
                pg8::gemm_phase<EpiSwiglu, pg8::StaticOrder, true, true>(lds, g, So, E, wave_s);
#ifdef PROBE_G1X2
                __syncthreads(); pg8::gemm_phase<EpiSwiglu, pg8::StaticOrder, true, true>(lds, g, So, E, wave_s);
#endif
#ifdef PROBE_G1X2B
                ++bar_round; grid_barrier((unsigned*)(ap->ws + WS_CTL), lds, wave_s);
                pg8::gemm_phase<EpiSwiglu, pg8::StaticOrder, true, true>(lds, g, So, E, wave_s);
#endif
            }
#endif
#ifndef SK_G2
            else if (idx == 2 || idx == 10 || idx == 13) {
                const bf16* A = (const bf16*)(ws + (idx == 10 ? WS_MERGED : WS_ACT)); const bf16* Bt = (const bf16*)(ws + (idx == 2 ? WS_WG2 : (idx == 10 ? WS_WOUT : WS_WG2B)));
                pg8::Gemm g{A, Bt, M, D, idx == 10 ? D : FF}; pg8::StaticOrder So; So.init(M, D, G, bid);
                EpiResid E{ap, l, idx};
#ifdef PROBE_G2NULL
                { EpiNull En{(float*)(ws + WS_CTL) + 900}; pg8::gemm_phase<EpiNull, pg8::StaticOrder, true, true>(lds, g, So, En, wave_s); __syncthreads(); }
#endif
                pg8::gemm_phase<EpiResid, pg8::StaticOrder, true, true>(lds, g, So, E, wave_s);
            }
#endif
#ifndef SK_IN
            else if (idx == 4) {
                const int nn = l == 0 ? 5376 : 5632;
                pg8::Gemm g{(const bf16*)(ws + WS_N), (const bf16*)(ws + WS_WIN), M, nn, D}; pg8::StaticOrder So; So.init(M, nn, G, bid);
                EpiIn E{ws, ap->out};
                pg8::gemm_phase<EpiIn, pg8::StaticOrder, true, true>(lds, g, So, E, wave_s);
#ifdef PROBE_IN2
                __syncthreads(); pg8::gemm_phase<EpiIn, pg8::StaticOrder, true, true>(lds, g, So, E, wave_s);
#endif
#ifdef PROBE_ALLB
                ++bar_round; grid_barrier((unsigned*)(ap->ws + WS_CTL), lds, wave_s); pg8::gemm_phase<EpiIn, pg8::StaticOrder, true, true>(lds, g, So, E, wave_s);
#endif
            }
#endif
#ifndef SK_PREP
            else if (idx == 5) {
                FRESH_TID(); phase_prep(ap, l, gw, NGW, lane);
#ifdef PROBE_THIN2
                phase_prep(ap, l, gw, NGW, lane, false);
#endif
            }
#endif
#ifndef SK_LORA
            else if (idx == 6) {
                pg8::Gemm g{(const bf16*)(ws + WS_ALORA), (const bf16*)(ws + WS_WLORA), M, 2048, 384};
                OffOrder So; So.b.init(M, 512, G, bid);
                So.off = 0; { EpiLora<0> E{ap, l}; pg8::gemm_phase<EpiLora<0>, OffOrder, true, true>(lds, g, So, E, wave_s); } __syncthreads();
#ifdef PROBE_LORA2
                So.off = 0; { EpiLora<0> E{ap, l}; pg8::gemm_phase<EpiLora<0>, OffOrder, true, true>(lds, g, So, E, wave_s); } __syncthreads();
                So.off = 4; { EpiLora<2> E{ap, l}; pg8::gemm_phase<EpiLora<2>, OffOrder, true, true>(lds, g, So, E, wave_s); } __syncthreads();
#endif
                So.off = 2; { EpiLora<1> E{ap, l}; pg8::gemm_phase<EpiLora<1>, OffOrder, true, true>(lds, g, So, E, wave_s); } __syncthreads();
                So.off = 4; { EpiLora<2> E{ap, l}; pg8::gemm_phase<EpiLora<2>, OffOrder, true, true>(lds, g, So, E, wave_s); } __syncthreads();
                if (l > 0) { So.off = 6; EpiLora<3> E{ap, l}; pg8::gemm_phase<EpiLora<3>, OffOrder, true, true>(lds, g, So, E, wave_s); }
            }
#endif
#ifndef SK_MIX
            else if (idx == 7) {
                phase_mixer(ap, lds, l, wave_s);
#ifdef PROBE_MIX2
                ++bar_round; grid_barrier((unsigned*)(ap->ws + WS_CTL), lds, wave_s); phase_mixer(ap, lds, l + 4, wave_s);
#endif
            }
#endif
#ifndef SK_UP
            else if (idx == 8) { FRESH_TID();
#ifdef PROBE_THIN2
                phase_scanfin(ap, l, gw, NGW, lane, false);
#endif
                phase_scanfin(ap, l, gw, NGW, lane); }
            else if (idx == 9) {
#if defined(PROBE_UP2) || defined(PROBE_ALLB)
              for (int rep = 0; rep < 2; ++rep) {
#endif
                { pg8::Gemm g{(const bf16*)(ws + WS_YA), (const bf16*)(ws + WS_WUPA), M, D, RW}; pg8::StaticOrder So; So.init(M, D, G, bid);
                  EpiUp<0> E{ws, ap->out};
                  pg8::gemm_phase<EpiUp<0>, pg8::StaticOrder, true, true>(lds, g, So, E, wave_s); }
                __syncthreads();
                { pg8::Gemm g{(const bf16*)(ws + WS_YB), (const bf16*)(ws + WS_WUPB), M, D, RW}; pg8::StaticOrder So; So.init(M, D, G, bid);
                  EpiUp<1> E{ws, ap->out};
                  pg8::gemm_phase<EpiUp<1>, pg8::StaticOrder, true, true>(lds, g, So, E, wave_s); }
#ifdef PROBE_UP2
                __syncthreads(); }
#endif
#ifdef PROBE_ALLB
                if (rep == 0) { ++bar_round; grid_barrier((unsigned*)(ap->ws + WS_CTL), lds, wave_s); } }
#endif
            }
#endif
        }
        if (ph + 1 < ph_hi) { ++bar_round; grid_barrier((unsigned*)(ap->ws + WS_CTL), lds, wave_s); }
#ifdef PROBE_BAR2
        if (ph + 1 < ph_hi) { ++bar_round; grid_barrier((unsigned*)(ap->ws + WS_CTL), lds, wave_s); }
#endif
    }
}

extern "C" void kernel_launch(void* const* d_in, const int* in_sizes, int n_in, void* d_out, int out_size, void* d_ws, size_t ws_size, hipStream_t stream) {
    static int grid = 0;
    if (grid == 0) {
        if (n_in != 31 || out_size != M * D || ws_size < WS_END) { fprintf(stderr, "kernel_launch: unexpected shapes (n_in %d, out %d, ws %zu < %zu)\n", n_in, out_size, ws_size, (size_t)WS_END); grid = -1; return; }
        int dev = 0, cus = 0, per_cu = 0;
        hipGetDevice(&dev); hipDeviceGetAttribute(&cus, hipDeviceAttributeMultiprocessorCount, dev);
        hipFuncSetAttribute((const void*)mk_fwd, hipFuncAttributeMaxDynamicSharedMemorySize, LDS_BYTES);
        hipOccupancyMaxActiveBlocksPerMultiprocessor(&per_cu, (const void*)mk_fwd, 512, LDS_BYTES);
        (void)hipGetLastError();
        if (per_cu < 1) per_cu = 1;
        grid = cus * per_cu;
    }
    if (grid < 0) return;
    hipMemsetAsync((char*)d_ws + WS_CTL, 0, 131072, stream);
    Args a{};
    for (int i = 0; i < 31; ++i) a.in[i] = (const float*)d_in[i];
    a.out = (float*)d_out; a.ws = (unsigned char*)d_ws; a.ph_lo = 0; a.ph_hi = NPHASES;
    void* args[] = {&a};
    hipError_t e = hipLaunchCooperativeKernel((const void*)mk_fwd, dim3(grid), dim3(512), args, LDS_BYTES, stream);
    if (e != hipSuccess) fprintf(stderr, "cooperative launch failed: %s (grid %d)\n", hipGetErrorString(e), grid);
}
```

```cpp
#include <hip/hip_runtime.h>
#include <hip/hip_cooperative_groups.h>
#include <cstdio>
#include <cstdint>
namespace cg = cooperative_groups;
namespace pg8 {
#define PG8_LAS __attribute__((address_space(3)))
typedef unsigned short bf16_t;
typedef _Float16 pg8_h8 __attribute__((ext_vector_type(8)));
typedef short bf16x8 __attribute__((ext_vector_type(8)));
typedef float f32x4 __attribute__((ext_vector_type(4)));
typedef unsigned u32x4 __attribute__((ext_vector_type(4)));
constexpr int BM = 256, BK = 64, HALF = 128, HTB = HALF * BK * 2  , STAGE_BYTES = 8 * HTB, NXCD = 8, WGM = 8;

__host__ __device__ __forceinline__ int lds_byte(int r, int c) { const int st = (r >> 4) * 2 + (c >> 5), rr = r & 15, cc = c & 31, ob = rr * 64 + cc * 2; return st * 1024 + (ob ^ (((ob >> 9) & 1) << 5)); }
__host__ __device__ __forceinline__ void stage_rc(int b, int& R, int& C) { const int st = b / 1024, sb = b % 1024, swz = sb ^ (((sb >> 9) & 1) << 5); R = (st >> 1) * 16 + swz / 64; C = (st & 1) * 32 + (swz % 64) / 2; }
__host__ __device__ __forceinline__ int perm32(int rho) { const int n = rho >> 4, i = rho & 15; return 8 * (i >> 2) + 4 * n + (i & 3); }

struct Unit { int pm, pn; };
struct Gemm { const bf16_t* A; const bf16_t* Bt; int M, N, K; };

struct StaticOrder {
    int nM, nN, nwg, G, c, wgm;
    __host__ __device__ void init(int M, int N, int G_, int c_, int wgm_ = 4) { nM = M / BM; nN = N / BM; nwg = nM * nN; G = G_; c = c_; wgm = wgm_; }
    __host__ __device__ bool next(int i, Unit& u) const {
        const long L = (long)i * G + c; if (L >= nwg) return false;
        int wgid = (int)L; { const int q = nwg / NXCD, r = nwg % NXCD, xcd = wgid % NXCD, off = wgid / NXCD; wgid = (xcd < r ? xcd * (q + 1) : r * (q + 1) + (xcd - r) * q) + off; }
        const int nig = wgm * nN, gid = wgid / nig, fm = gid * wgm, gsz = (nM - fm) < wgm ? (nM - fm) : wgm;
        u.pm = fm + ((wgid % nig) % gsz); u.pn = (wgid % nig) / gsz; return true;
    }
    __device__ __forceinline__ void a_ready(const Unit&) const {}
    __device__ __forceinline__ void done(const Unit&) const {}
};

__device__ __forceinline__ unsigned cvt_pk_bf16(float lo, float hi) { unsigned r; asm volatile("v_cvt_pk_bf16_f32 %0, %1, %2" : "=v"(r) : "v"(lo), "v"(hi)); return r; }
template <class Epi, class Sched, bool ALIGN_EPI = false, bool SP2 = false>
__device__ __forceinline__ void gemm_phase(PG8_LAS unsigned char* lds, const Gemm g, const Sched& S, const Epi& E, const int wave_s) {
    int lane_; asm volatile("v_mbcnt_lo_u32_b32 %0, -1, 0\n\tv_mbcnt_hi_u32_b32 %0, -1, %0" : "=v"(lane_));
    const int wid = wave_s, lane = lane_, tid = wid * 64 + lane, wr = wid >> 2, wc = wid & 3, fr = lane & 15, fq = lane >> 4;
    const int K = g.K, nt = K / BK;
    unsigned voffA[2], voffB[2];
#pragma unroll
    for (int i = 0; i < 2; ++i) { int R, C; stage_rc(tid * 16 + i * 8192, R, C); const int Rb = Epi::PERM ? ((R & ~31) + perm32(R & 31)) : R;
        voffA[i] = (unsigned)(R * K + C) * 2u; voffB[i] = (unsigned)(Rb * K + C) * 2u; }
    const size_t kstep = (size_t)(BK * 2);
    const size_t hstep = (size_t)HALF * K * 2;
    const size_t tstep = 2 * hstep;
    const unsigned ldsw = (unsigned)wid * 1024u;
    const int aoff = lds_byte(wr * 64 + fr, fq * 8), boff = lds_byte(wc * 32 + fr, fq * 8);
#define PG8_SA(b, h) (((b) * 2 + (h)) * HTB)
#define PG8_SB(b, h) ((4 + (b) * 2 + (h)) * HTB)
#define PG8_STAGE(bufoff, gbase, voff) do { _Pragma("unroll") for (int _i = 0; _i < 2; ++_i) \
        __builtin_amdgcn_global_load_lds((const unsigned*)((const char*)(gbase) + (voff)[_i]), (PG8_LAS unsigned*)(lds + (bufoff) + ldsw + _i * 8192), 16, 0, 0); } while (0)
#define PG8_LDA(dst, b, h) do { _Pragma("unroll") for (int m = 0; m < 4; ++m) _Pragma("unroll") for (int k = 0; k < 2; ++k) dst[m][k] = *(const PG8_LAS bf16x8*)(lds + PG8_SA(b, h) + aoff + m * 2048 + k * 1024); } while (0)
#define PG8_LDB(dst, b, h) do { _Pragma("unroll") for (int n = 0; n < 2; ++n) _Pragma("unroll") for (int k = 0; k < 2; ++k) dst[n][k] = *(const PG8_LAS bf16x8*)(lds + PG8_SB(b, h) + boff + n * 2048 + k * 1024); } while (0)
#define PG8_MMA(ai, bj, At, Bt) do { __builtin_amdgcn_s_setprio(1); _Pragma("unroll") for (int m = 0; m < 4; ++m) _Pragma("unroll") for (int n = 0; n < 2; ++n) _Pragma("unroll") for (int k = 0; k < 2; ++k) \
        acc[ai][bj][m][n] = __builtin_amdgcn_mfma_f32_16x16x32_f16(__builtin_bit_cast(pg8_h8, Bt[n][k]), __builtin_bit_cast(pg8_h8, At[m][k]), acc[ai][bj][m][n], 0, 0, 0); __builtin_amdgcn_s_setprio(0); } while (0)
#define PG8_WAIT_V(n) asm volatile("s_waitcnt vmcnt(" #n ")" ::: "memory")
#define PG8_WAIT_L(n) asm volatile("s_waitcnt lgkmcnt(" #n ")" ::: "memory")
#define PG8_BAR __builtin_amdgcn_s_barrier()
#define PG8_SCHED __builtin_amdgcn_sched_barrier(0)
    Unit cur, nxt; int ui = 0;
    if (!S.next(0, cur)) return;
    f32x4 acc[2][2][4][2];
#pragma unroll
    for (int a = 0; a < 2; ++a)
#pragma unroll
        for (int b = 0; b < 2; ++b)
#pragma unroll
            for (int m = 0; m < 4; ++m)
#pragma unroll
                for (int n = 0; n < 2; ++n) acc[a][b][m][n] = (f32x4){0.f, 0.f, 0.f, 0.f};
    bf16x8 At[4][2], B0[2][2], B1[2][2];
    const char* cA = (const char*)g.A + (size_t)cur.pm * tstep; const char* cB = (const char*)g.Bt + (size_t)cur.pn * tstep;
    S.a_ready(cur);
    if constexpr (SP2) {
        PG8_STAGE(PG8_SB(0, 0), cB, voffB); PG8_STAGE(PG8_SB(0, 1), cB + hstep, voffB); PG8_STAGE(PG8_SA(0, 0), cA, voffA); PG8_STAGE(PG8_SA(0, 1), cA + hstep, voffA);
        if (wr == 1) PG8_BAR;
        PG8_WAIT_V(2); PG8_BAR;
        PG8_STAGE(PG8_SB(1, 0), cB + kstep, voffB); PG8_STAGE(PG8_SA(1, 0), cA + kstep, voffA); PG8_STAGE(PG8_SB(1, 1), cB + hstep + kstep, voffB);
        PG8_WAIT_V(6); PG8_BAR;
    } else {
        PG8_STAGE(PG8_SB(0, 0), cB, voffB); PG8_STAGE(PG8_SA(0, 0), cA, voffA); PG8_STAGE(PG8_SB(0, 1), cB + hstep, voffB); PG8_STAGE(PG8_SA(0, 1), cA + hstep, voffA);
        if (wr == 1) PG8_BAR;
        PG8_WAIT_V(4); PG8_BAR;
        PG8_STAGE(PG8_SB(1, 0), cB + kstep, voffB); PG8_STAGE(PG8_SA(1, 0), cA + kstep, voffA); PG8_STAGE(PG8_SB(1, 1), cB + hstep + kstep, voffB);
        PG8_WAIT_V(6); PG8_BAR;
    }
    for (;;) {
        const bool has_next = S.next(ui + 1, nxt);
        const char* nA = has_next ? (const char*)g.A + (size_t)nxt.pm * tstep : cA; const char* nB = has_next ? (const char*)g.Bt + (size_t)nxt.pn * tstep : cB;
        for (int t = 0; t < nt; t += 2) {
            const bool last = (t == nt - 2);
            const char* a1 = cA + (size_t)(t + 1) * kstep;
            const char* a2 = last ? nA : cA + (size_t)(t + 2) * kstep; const char* b2 = last ? nB : cB + (size_t)(t + 2) * kstep;
            const char* a3 = a2 + kstep; const char* b3 = b2 + kstep;
            if (last && has_next) S.a_ready(nxt);
            if constexpr (SP2) {
            PG8_LDB(B0, 0, 0); PG8_LDB(B1, 0, 1); PG8_SCHED; PG8_LDA(At, 0, 0); PG8_STAGE(PG8_SA(1, 1), a1 + hstep, voffA);
            PG8_WAIT_V(8); PG8_WAIT_L(0); PG8_BAR; PG8_MMA(0, 0, At, B0); PG8_MMA(0, 1, At, B1); PG8_BAR; PG8_SCHED;
            PG8_LDA(At, 0, 1); PG8_STAGE(PG8_SB(0, 0), b2, voffB); PG8_STAGE(PG8_SB(0, 1), b2 + hstep, voffB); PG8_STAGE(PG8_SA(0, 0), a2, voffA);
            PG8_WAIT_V(8); PG8_WAIT_L(0); PG8_BAR; PG8_MMA(1, 0, At, B0); PG8_MMA(1, 1, At, B1); PG8_BAR; PG8_SCHED;
            PG8_LDB(B0, 1, 0); PG8_LDB(B1, 1, 1); PG8_SCHED; PG8_LDA(At, 1, 0); PG8_STAGE(PG8_SA(0, 1), a2 + hstep, voffA);
            PG8_WAIT_V(8); PG8_WAIT_L(0); PG8_BAR; PG8_MMA(0, 0, At, B0); PG8_MMA(0, 1, At, B1); PG8_BAR; PG8_SCHED;
            PG8_LDA(At, 1, 1); PG8_STAGE(PG8_SB(1, 0), b3, voffB); PG8_STAGE(PG8_SB(1, 1), b3 + hstep, voffB); PG8_STAGE(PG8_SA(1, 0), a3, voffA);
            PG8_WAIT_V(8); PG8_WAIT_L(0); PG8_BAR; PG8_MMA(1, 0, At, B0); PG8_MMA(1, 1, At, B1); PG8_BAR; PG8_SCHED;
            } else {
            PG8_LDB(B0, 0, 0); PG8_SCHED; PG8_LDA(At, 0, 0); PG8_STAGE(PG8_SA(1, 1), a1 + hstep, voffA);
            PG8_WAIT_L(8); PG8_BAR; PG8_WAIT_L(0); PG8_MMA(0, 0, At, B0); PG8_BAR; PG8_SCHED;
            PG8_LDB(B1, 0, 1); PG8_STAGE(PG8_SB(0, 0), b2, voffB);
            PG8_BAR; PG8_WAIT_L(0); PG8_MMA(0, 1, At, B1); PG8_BAR;
            PG8_LDA(At, 0, 1); PG8_STAGE(PG8_SA(0, 0), a2, voffA);
            PG8_BAR; PG8_WAIT_L(0); PG8_MMA(1, 0, At, B0); PG8_BAR; PG8_SCHED;
            PG8_STAGE(PG8_SB(0, 1), b2 + hstep, voffB);
            PG8_WAIT_V(6); PG8_BAR; PG8_MMA(1, 1, At, B1); PG8_BAR;
            PG8_LDB(B0, 1, 0); PG8_SCHED; PG8_LDA(At, 1, 0); PG8_STAGE(PG8_SA(0, 1), a2 + hstep, voffA);
            PG8_WAIT_L(8); PG8_BAR; PG8_WAIT_L(0); PG8_MMA(0, 0, At, B0); PG8_BAR; PG8_SCHED;
            PG8_LDB(B1, 1, 1); PG8_STAGE(PG8_SB(1, 0), b3, voffB);
            PG8_BAR; PG8_WAIT_L(0); PG8_MMA(0, 1, At, B1); PG8_BAR;
            PG8_LDA(At, 1, 1); PG8_STAGE(PG8_SA(1, 0), a3, voffA);
            PG8_BAR; PG8_WAIT_L(0); PG8_MMA(1, 0, At, B0); PG8_BAR; PG8_SCHED;
            PG8_STAGE(PG8_SB(1, 1), b3 + hstep, voffB);
            PG8_WAIT_V(6); PG8_BAR; PG8_MMA(1, 1, At, B1); PG8_BAR;
            }
        }
        if constexpr (ALIGN_EPI) { if (wr == 0) PG8_BAR; }
        if constexpr (!Epi::AFTER_DRAIN) { E(acc, cur, wr, wc, fr, fq); S.done(cur); }
        if (!has_next) break;
#pragma unroll
        for (int a = 0; a < 2; ++a)
#pragma unroll
            for (int b = 0; b < 2; ++b)
#pragma unroll
                for (int m = 0; m < 4; ++m)
#pragma unroll
                    for (int n = 0; n < 2; ++n) acc[a][b][m][n] = (f32x4){0.f, 0.f, 0.f, 0.f};
        cur = nxt; cA = nA; cB = nB; ++ui;
        if constexpr (ALIGN_EPI) { if (wr == 1) PG8_BAR; }
    }
    PG8_WAIT_V(0);
    if constexpr (!ALIGN_EPI) { if (wr == 0) PG8_BAR; }
    PG8_BAR;
    if constexpr (Epi::AFTER_DRAIN) { E.fused(acc, cur, wr, wc, fr, fq, lds, wid, lane); S.done(cur); }
#undef PG8_SA
#undef PG8_SB
#undef PG8_STAGE
#undef PG8_LDA
#undef PG8_LDB
#undef PG8_MMA
#undef PG8_WAIT_V
#undef PG8_WAIT_L
#undef PG8_BAR
#undef PG8_SCHED
}
}
#define LAS __attribute__((address_space(3)))
typedef unsigned short bf16;
typedef unsigned v4u __attribute__((ext_vector_type(4)));
typedef unsigned v2u __attribute__((ext_vector_type(2)));
typedef float f32x4 __attribute__((ext_vector_type(4)));
typedef float f32x2 __attribute__((ext_vector_type(2)));
typedef float f32x16 __attribute__((ext_vector_type(16)));
typedef short bf16x8 __attribute__((ext_vector_type(8)));

constexpr int NB = 8, S = 4096, M = NB * S, D = 1024, FF = 2816, NH = 8, HD = 64, RW = 512;
constexpr int PRW_LD = 1824, NPH_LAYER = 14, NPHASES = 1 + 4 * NPH_LAYER;
constexpr float LOG2E = 1.4426950408889634f, LN2 = 0.6931471805599453f;
constexpr size_t MiB = 1u << 20, HM = MiB / 2;
constexpr size_t WS_CTL = 0, WS_MOD = 1 * MiB;
constexpr size_t WS_WG1 = 3 * MiB, WS_WG2 = 14 * MiB, WS_WIN = 19 * MiB + HM, WS_WUPA = 30 * MiB + HM, WS_WUPB = 31 * MiB + HM, WS_WOUT = 32 * MiB + HM,
                 WS_WG1B = 34 * MiB + HM, WS_WG2B = 45 * MiB + HM, WS_WLORA = 51 * MiB;
constexpr size_t WS_PRW = 53 * MiB, WS_Q = 167 * MiB, WS_K = 199 * MiB, WS_VT = 231 * MiB, WS_H16 = 263 * MiB, WS_ACT = 53 * MiB;
constexpr size_t WS_WL2 = 53 * MiB, WS_BB = 85 * MiB, WS_GG = 117 * MiB, WS_MERGED = 53 * MiB;
constexpr size_t WS_R = 391 * MiB, WS_KM = 423 * MiB, WS_KK = 455 * MiB, WS_VV = 487 * MiB, WS_N = 391 * MiB, WS_TEMP = 391 * MiB;
constexpr size_t WS_YA = 519 * MiB, WS_YB = 551 * MiB, WS_ALORA = 519 * MiB, WS_VFIRST = 583 * MiB, WS_BONUS = 615 * MiB, WS_END = 616 * MiB;
constexpr int LDS_BYTES = 147456, MISC_OFF = 131072;

typedef _Float16 h16x2 __attribute__((ext_vector_type(2)));
typedef _Float16 h16x8 __attribute__((ext_vector_type(8)));
__device__ __forceinline__ unsigned f2bf(float f) { return (unsigned)__builtin_bit_cast(unsigned short, (_Float16)f); }
__device__ __forceinline__ unsigned pk2(float lo, float hi) { const h16x2 v = {(_Float16)lo, (_Float16)hi}; return __builtin_bit_cast(unsigned, v); }
__device__ __forceinline__ float bflo(unsigned u) { const h16x2 v = __builtin_bit_cast(h16x2, u); return (float)v.x; }
__device__ __forceinline__ float bfhi(unsigned u) { const h16x2 v = __builtin_bit_cast(h16x2, u); return (float)v.y; }
__device__ __forceinline__ float fexp(float x) { return __builtin_amdgcn_exp2f(x * LOG2E); }
__device__ __forceinline__ float flog(float x) { return __builtin_amdgcn_logf(x) * LN2; }
__device__ __forceinline__ float sigmoidf_(float x) { return __builtin_amdgcn_rcpf(1.f + fexp(-x)); }
#define SHX(v, o) __uint_as_float(__builtin_amdgcn_ds_bpermute(((lane) ^ (o)) << 2, __float_as_uint(v)))
__device__ __forceinline__ float wave_sum(float v, int lane) {
#pragma unroll
    for (int o = 1; o < 64; o <<= 1) v += SHX(v, o);
    return v;
}
template <int CTRL> __device__ __forceinline__ float dppf(float x) { return __uint_as_float(__builtin_amdgcn_update_dpp(0u, __float_as_uint(x), CTRL, 0xf, 0xf, false)); }
__device__ __forceinline__ float red16(float x) { x += dppf<0x128>(x); x += dppf<0x124>(x); x += dppf<0x122>(x); x += dppf<0x121>(x); return x; }
#define LDS_WAIT() asm volatile("s_waitcnt lgkmcnt(0)" ::: "memory")

struct Args { const float* in[31]; float* out; unsigned char* ws; int ph_lo, ph_hi; };
typedef const __attribute__((address_space(4))) Args* CArgs;
#define EPI_FENCE() asm volatile("" ::: "memory")

__device__ __forceinline__ int fresh_lane() { int ln; asm volatile("v_mbcnt_lo_u32_b32 %0, -1, 0\n\tv_mbcnt_hi_u32_b32 %0, -1, %0" : "=v"(ln)); return ln; }
#define EPI_IDX() const int t_ = fresh_lane(); const int fr = t_ & 15, fq = t_ >> 4
__device__ __forceinline__ v4u pack8(const f32x4 a, const f32x4 b);
struct EpiSwiglu {
    static constexpr bool PERM = true, AFTER_DRAIN = false;
    bf16* act;
    __device__ __forceinline__ void operator()(const f32x4 (&acc)[2][2][4][2], const pg8::Unit& u, int wr, int wc, int, int) const {
        EPI_IDX();
        const int row0 = u.pm * 256 + wr * 64 + fr, f0 = u.pn * 128 + wc * 32 + fq * 8;
#pragma unroll
        for (int ai = 0; ai < 2; ++ai)
#pragma unroll
            for (int m = 0; m < 4; ++m) { bf16* rp = act + (size_t)(row0 + ai * 128 + m * 16) * FF + f0; f32x4 o[2];
#pragma unroll
                for (int n = 0; n < 2; ++n) { const f32x4 g = acc[ai][0][m][n], uu = acc[ai][1][m][n];
#pragma unroll
                    for (int j = 0; j < 4; ++j) o[n][j] = g[j] * uu[j] * __builtin_amdgcn_rcpf(1.f + __builtin_amdgcn_exp2f(-g[j] * LOG2E)); }
                *(v4u*)rp = pack8(o[0], o[1]);
                EPI_FENCE(); }
    }
};
struct EpiResid {
    static constexpr bool PERM = true, AFTER_DRAIN = false;
    CArgs a; int l, idx;
    __device__ __forceinline__ void operator()(const f32x4 (&acc)[2][2][4][2], const pg8::Unit& u, int wr, int wc, int, int) const {
        EPI_IDX();
        unsigned char* ws = a->ws; const float* mod = (const float*)(ws + WS_MOD);
        const bool in32 = (l == 0 && idx == 2), out32 = (l == 3 && idx == 13);
        const float* x32 = a->in[0]; float* o32 = a->out; bf16* h16 = (bf16*)(ws + WS_H16);
        const float* gt = mod + (size_t)l * 8 * 9216 + (idx == 2 ? 2 : (idx == 10 ? 5 : 8)) * 1024; const float fac = idx == 10 ? 1.f : 0.5f;
        const int row0 = u.pm * 256 + wr * 64 + fr, col0 = u.pn * 256 + wc * 32 + 8 * fq, b = u.pm >> 4;
#pragma unroll
        for (int bj = 0; bj < 2; ++bj) { const int col = col0 + bj * 128; const f32x4 g0 = *(const f32x4*)(gt + b * 9216 + col) * fac, g1 = *(const f32x4*)(gt + b * 9216 + col + 4) * fac;
#pragma unroll
            for (int ai = 0; ai < 2; ++ai)
#pragma unroll
                for (int m = 0; m < 4; ++m) { const size_t off = (size_t)(row0 + ai * 128 + m * 16) * D + col; f32x4 h0, h1;
                    if (in32) { h0 = *(const f32x4*)(x32 + off); h1 = *(const f32x4*)(x32 + off + 4); }
                    else { const v4u q = *(const v4u*)(h16 + off); h0 = (f32x4){bflo(q.x), bfhi(q.x), bflo(q.y), bfhi(q.y)}; h1 = (f32x4){bflo(q.z), bfhi(q.z), bflo(q.w), bfhi(q.w)}; }
                    const f32x4 o0 = h0 + g0 * acc[ai][bj][m][0], o1 = h1 + g1 * acc[ai][bj][m][1];
                    if (out32) { *(f32x4*)(o32 + off) = o0; *(f32x4*)(o32 + off + 4) = o1; }
                    else { v4u w; w.x = pk2(o0[0], o0[1]); w.y = pk2(o0[2], o0[3]); w.z = pk2(o1[0], o1[1]); w.w = pk2(o1[2], o1[3]); *(v4u*)(h16 + off) = w; }
                    if (m & 1) EPI_FENCE(); } }
    }
};
__device__ __forceinline__ v4u pack8(const f32x4 a, const f32x4 b) { v4u w; w.x = pk2(a[0], a[1]); w.y = pk2(a[2], a[3]); w.z = pk2(b[0], b[1]); w.w = pk2(b[2], b[3]); return w; }
struct EpiIn {
    static constexpr bool PERM = true, AFTER_DRAIN = false;
    unsigned char* ws; float* gates_base;
    __device__ __forceinline__ void operator()(const f32x4 (&acc)[2][2][4][2], const pg8::Unit& u, int wr, int wc, int, int) const {
        EPI_IDX();
        const int row0 = u.pm * 256 + wr * 64 + fr, pn = u.pn;
        bf16 *prw = (bf16*)(ws + WS_PRW), *q = (bf16*)(ws + WS_Q), *k = (bf16*)(ws + WS_K), *vt = (bf16*)(ws + WS_VT), *gates = (bf16*)gates_base;
#pragma unroll
        for (int ai = 0; ai < 2; ++ai)
#pragma unroll
            for (int m = 0; m < 4; ++m) { const int row = row0 + ai * 128 + m * 16;
#pragma unroll
                for (int bj = 0; bj < 2; ++bj) { const int col = pn * 256 + bj * 128 + wc * 32 + 8 * fq; const f32x4 v0 = acc[ai][bj][m][0], v1 = acc[ai][bj][m][1];
                    if (pn < 7) { *(v4u*)(prw + (size_t)row * PRW_LD + col) = pack8(v0, v1); }
                    else if (pn < 13) { const int c2 = col - 1792, which = c2 >> 9, hd = c2 & 511, hh = hd >> 6, d = hd & 63, b = row >> 12, s = row & 4095;
                        if (which < 2) { bf16* dst = (which ? k : q) + ((size_t)((b * NH + hh) * S + s)) * HD + d; *(v4u*)dst = pack8(v0, v1); }
                        else { bf16* dst = vt + ((size_t)((b * NH + hh) * HD + d)) * S + s;
#pragma unroll
                            for (int e = 0; e < 4; ++e) { dst[(size_t)e * S] = (bf16)f2bf(v0[e]); dst[(size_t)(e + 4) * S] = (bf16)f2bf(v1[e]); } } }
                    else if (pn < 21) { *(v4u*)(gates + (size_t)row * 2048 + (col - 3328)) = pack8(v0, v1); }
                    else { if (col < 5408) *(v4u*)(prw + (size_t)row * PRW_LD + 1792 + (col - 5376)) = pack8(v0, v1); } }
                EPI_FENCE(); }
    }
};
__device__ __forceinline__ f32x4 unpack4(const v2u q) { return (f32x4){bflo(q.x), bfhi(q.x), bflo(q.y), bfhi(q.y)}; }
__device__ __forceinline__ v2u pack4(const f32x4 a) { v2u w; w.x = pk2(a[0], a[1]); w.y = pk2(a[2], a[3]); return w; }
template <int GRPT> struct EpiLora {
    static constexpr bool PERM = true, AFTER_DRAIN = false;
    CArgs a; int l;
    template <int GRP> __device__ __forceinline__ void run(const f32x4 (&acc)[2][2][4][2], const pg8::Unit& u, int wr, int wc, int, int) const {
        EPI_IDX();
        const int row0 = u.pm * 256 + wr * 64 + fr;
        unsigned char* ws = a->ws;
        bf16 *km = (bf16*)(ws + WS_KM), *kk = (bf16*)(ws + WS_KK), *vv = (bf16*)(ws + WS_VV), *wl2 = (bf16*)(ws + WS_WL2), *bb = (bf16*)(ws + WS_BB), *gg = (bf16*)(ws + WS_GG); const bf16* vfirst = (const bf16*)(ws + WS_VFIRST);
        const float* pv = GRP == 0 ? a->in[11] + l * 512 : (GRP == 1 ? a->in[13] + l * 512 : a->in[21] + (l > 0 ? (l - 1) * 512 : 0));
        const float* ka = a->in[17] + l * 512;
#pragma unroll
        for (int bj = 0; bj < 2; ++bj)
#pragma unroll
            for (int n = 0; n < 2; ++n) { const int ch = (u.pn & 1) * 256 + bj * 128 + wc * 32 + 8 * fq + 4 * n;
                f32x4 c0 = (f32x4){0.f, 0.f, 0.f, 0.f}, ka0 = c0;
                if (GRP != 2) c0 = *(const f32x4*)(pv + ch);
                if (GRP == 1) ka0 = *(const f32x4*)(ka + ch);
#pragma unroll
                for (int ai = 0; ai < 2; ++ai)
#pragma unroll
                    for (int m = 0; m < 4; ++m) { const size_t off = (size_t)(row0 + ai * 128 + m * 16) * RW + ch; f32x4 x0 = acc[ai][bj][m][n] + c0;
                        if (GRP == 0) {
#pragma unroll
                            for (int e = 0; e < 4; ++e) { const float p = -x0[e]; const float sp = fmaxf(p, 0.f) + flog(1.f + fexp(-fabsf(p))); x0[e] = -fexp(-sp - 0.5f) * LOG2E; }
                            *(v2u*)(wl2 + off) = pack4(x0);
                        } else if (GRP == 1) { f32x4 k0 = unpack4(*(const v2u*)(km + off)), n0 = unpack4(*(const v2u*)(kk + off));
#pragma unroll
                            for (int e = 0; e < 4; ++e) { const float s0 = sigmoidf_(x0[e]); k0[e] = k0[e] * (1.f + (s0 - 1.f) * ka0[e]); n0[e] *= s0; }
                            *(v2u*)(km + off) = pack4(k0); *(v2u*)(bb + off) = pack4(n0);
                        } else if (GRP == 2) { *(v2u*)(gg + off) = pack4(x0);
                        } else { f32x4 a0_ = unpack4(*(const v2u*)(vv + off)); const f32x4 f0 = unpack4(*(const v2u*)(vfirst + off));
#pragma unroll
                            for (int e = 0; e < 4; ++e) a0_[e] += (f0[e] - a0_[e]) * sigmoidf_(x0[e]);
                            *(v2u*)(vv + off) = pack4(a0_); }
                        EPI_FENCE(); } }
    }
    __device__ __forceinline__ void operator()(const f32x4 (&acc)[2][2][4][2], const pg8::Unit& u, int wr, int wc, int, int) const { run<GRPT>(acc, u, wr, wc, 0, 0); }
};
struct EpiNull {
    static constexpr bool PERM = false, AFTER_DRAIN = false;
    float* sink;
    __device__ __forceinline__ void operator()(const f32x4 (&acc)[2][2][4][2], const pg8::Unit& u, int wr, int wc, int, int) const {
        float s = 0.f;
#pragma unroll
        for (int ai = 0; ai < 2; ++ai)
#pragma unroll
            for (int bj = 0; bj < 2; ++bj)
#pragma unroll
                for (int m = 0; m < 4; ++m)
#pragma unroll
                    for (int n = 0; n < 2; ++n) s += acc[ai][bj][m][n][0] + acc[ai][bj][m][n][1] + acc[ai][bj][m][n][2] + acc[ai][bj][m][n][3];
        if (s == 12345.678f) sink[0] = s;
    }
};
struct OffOrder {
    pg8::StaticOrder b; int off;
    __device__ bool next(int i, pg8::Unit& u) const { if (!b.next(i, u)) return false; u.pn += off; return true; }
    __device__ __forceinline__ void a_ready(const pg8::Unit&) const {}
    __device__ __forceinline__ void done(const pg8::Unit&) const {}
};
__device__ __forceinline__ void unpack8(const v4u q, float* x);
__device__ __forceinline__ v4u packarr(const float* x);
template <int SECOND> struct EpiUp {
    static constexpr bool PERM = true, AFTER_DRAIN = false;
    unsigned char* ws; const float* gates_base;
    __device__ __forceinline__ void operator()(const f32x4 (&acc)[2][2][4][2], const pg8::Unit& u, int wr, int wc, int, int) const {
        EPI_IDX();
        const int row0 = u.pm * 256 + wr * 64 + fr;
        const bf16* gates = (const bf16*)gates_base; bf16* merged = (bf16*)(ws + WS_MERGED);
#pragma unroll
        for (int ai = 0; ai < 2; ++ai)
#pragma unroll
            for (int m = 0; m < 4; ++m) { const int row = row0 + ai * 128 + m * 16;
#pragma unroll
                for (int bj = 0; bj < 2; ++bj) { const int col = u.pn * 256 + bj * 128 + wc * 32 + 8 * fq;
                    float g[8]; unpack8(*(const v4u*)(gates + (size_t)row * 2048 + SECOND * 1024 + col), g);
                    bf16* mp = merged + (size_t)row * D + col;
                    float o[8];
#pragma unroll
                    for (int e = 0; e < 4; ++e) { o[e] = sigmoidf_(g[e]) * acc[ai][bj][m][0][e]; o[e + 4] = sigmoidf_(g[e + 4]) * acc[ai][bj][m][1][e]; }
                    if (SECOND == 1) { float p[8]; unpack8(*(const v4u*)mp, p);
#pragma unroll
                        for (int e = 0; e < 8; ++e) o[e] += p[e]; }
                    *(v4u*)mp = packarr(o); }
                EPI_FENCE(); }
    }
};

__device__ __forceinline__ void phase_mod(CArgs a, LAS unsigned char* lds, int tid, int bid, int G) {
    LAS float* sc = (LAS float*)lds;
    LAS float* red = (LAS float*)(lds + 32768);
    float* mod = (float*)(a->ws + WS_MOD);
    const float* c = a->in[1];
    bool loaded = false;
    for (int it = bid; it < 144; it += G) {
        if (!loaded) { for (int i = tid; i < 8192; i += 512) { const int b = i >> 10, k = i & 1023; const float v = c[i]; sc[k * 8 + b] = v * sigmoidf_(v); } loaded = true; }
        __syncthreads();
        const int l = it / 36, j0 = (it % 36) * 256, ln = tid & 63, kq = tid >> 6;
        const float* w = a->in[2] + (size_t)l * 1024 * 9216 + j0 + 4 * ln;
        f32x4 a0[4], a1[4];
#pragma unroll
        for (int q = 0; q < 4; ++q) { a0[q] = (f32x4){0.f, 0.f, 0.f, 0.f}; a1[q] = a0[q]; }
#pragma unroll 8
        for (int k = kq * 128; k < kq * 128 + 128; ++k) { const f32x4 wv = *(const f32x4*)(w + (size_t)k * 9216); const f32x4 s0 = *(LAS const f32x4*)(sc + k * 8), s1 = *(LAS const f32x4*)(sc + k * 8 + 4);
#pragma unroll
            for (int q = 0; q < 4; ++q) { a0[q] += wv[q] * s0; a1[q] += wv[q] * s1; } }
#pragma unroll
        for (int q = 0; q < 4; ++q) { *(LAS f32x4*)(red + ((kq * 256 + 4 * ln + q) * 8)) = a0[q]; *(LAS f32x4*)(red + ((kq * 256 + 4 * ln + q) * 8) + 4) = a1[q]; }
        __syncthreads();
        for (int o = tid; o < 2048; o += 512) { const int cc = o >> 3, bq = o & 7; float sum = 0.f;
#pragma unroll
            for (int q = 0; q < 8; ++q) sum += red[(q * 256 + cc) * 8 + bq];
            mod[(size_t)(l * 8 + bq) * 9216 + j0 + cc] = sum + a->in[3][l * 9216 + j0 + cc]; }
        __syncthreads();
    }
}
template <int MAP> __device__ __forceinline__ void tr_item(const float* W, int K, int N, bf16* WT, LAS float* scr, int item, int lane) {
    const int nblk = N / 32, kb = item / nblk, nb = item % nblk, k0 = 64 * kb, n0 = 32 * nb;
    {
        const int nq = (lane & 7) * 4;
#pragma unroll
        for (int i = 0; i < 8; ++i) { const int kk = 8 * i + (lane >> 3); const f32x4 w4 = *(const f32x4*)(W + (size_t)(k0 + kk) * N + n0 + nq);
            LAS float* d = scr + kk * 33 + nq; d[0] = w4.x; d[1] = w4.y; d[2] = w4.z; d[3] = w4.w; } }
    LDS_WAIT();
    const int c = lane & 7;
#pragma unroll
    for (int j = 0; j < 4; ++j) { const int n = (lane >> 3) + 8 * j; const LAS float* s = scr + (8 * c) * 33 + n;
        v4u o; o.x = pk2(s[0 * 33], s[1 * 33]); o.y = pk2(s[2 * 33], s[3 * 33]); o.z = pk2(s[4 * 33], s[5 * 33]); o.w = pk2(s[6 * 33], s[7 * 33]);
        const int nn = n0 + n; const int dr = MAP == 0 ? nn : ((nn >> 7) * 256 + (MAP == 2 ? 128 : 0) + (nn & 127));
        *(v4u*)(WT + (size_t)dr * K + k0 + 8 * c) = o; }
    LDS_WAIT();
}
__device__ __forceinline__ void phase_convert(CArgs a, LAS unsigned char* lds, int l, int gw, int NGW, int wave, int lane, int gtid, int GT) {
    LAS float* scr = (LAS float*)(lds + wave * 16384);
    unsigned char* ws = a->ws;
    const size_t fo = (size_t)l * 1024 * FF;
    const int nin = l == 0 ? 5376 : 5408;
    const float* win = l == 0 ? a->in[8] : a->in[9] + (size_t)(l - 1) * 1024 * 5408;
    const int I_F = 1408, I_IN = 16 * (nin / 32), I_UP = 256, I_OUT = 512;
    const int total = 6 * I_F + I_IN + 2 * I_UP + I_OUT;
    for (int it = gw; it < total; it += NGW) {
        int r = it;
        if (r < I_F) { tr_item<1>(a->in[5] + fo, 1024, FF, (bf16*)(ws + WS_WG1), scr, r, lane); continue; } r -= I_F;
        if (r < I_F) { tr_item<2>(a->in[6] + fo, 1024, FF, (bf16*)(ws + WS_WG1), scr, r, lane); continue; } r -= I_F;
        if (r < I_F) { tr_item<0>(a->in[7] + fo, FF, 1024, (bf16*)(ws + WS_WG2), scr, r, lane); continue; } r -= I_F;
        if (r < I_F) { tr_item<1>(a->in[28] + fo, 1024, FF, (bf16*)(ws + WS_WG1B), scr, r, lane); continue; } r -= I_F;
        if (r < I_F) { tr_item<2>(a->in[29] + fo, 1024, FF, (bf16*)(ws + WS_WG1B), scr, r, lane); continue; } r -= I_F;
        if (r < I_F) { tr_item<0>(a->in[30] + fo, FF, 1024, (bf16*)(ws + WS_WG2B), scr, r, lane); continue; } r -= I_F;
        if (r < I_IN) { tr_item<0>(win, 1024, nin, (bf16*)(ws + WS_WIN), scr, r, lane); continue; } r -= I_IN;
        if (r < I_UP) { tr_item<0>(a->in[25] + (size_t)l * 512 * 1024, 512, 1024, (bf16*)(ws + WS_WUPA), scr, r, lane); continue; } r -= I_UP;
        if (r < I_UP) { tr_item<0>(a->in[26] + (size_t)l * 512 * 1024, 512, 1024, (bf16*)(ws + WS_WUPB), scr, r, lane); continue; } r -= I_UP;
        tr_item<0>(a->in[27] + (size_t)l * 1024 * 1024, 1024, 1024, (bf16*)(ws + WS_WOUT), scr, r, lane);
    }
    bf16* wl = (bf16*)(ws + WS_WLORA);
    for (int ci = gtid; ci < 2048 * 48; ci += GT) { const int n = ci / 48, kc = ci % 48, grp = n >> 9, ch = n & 511; float v[8];
#pragma unroll
        for (int e = 0; e < 8; ++e) { const int kk = kc * 8 + e; float x = 0.f;
            if (grp == 0) { if (kk < 64) x = a->in[12][((size_t)l * 64 + kk) * 512 + ch]; }
            else if (grp == 1) { if (kk >= 64 && kk < 128) x = a->in[14][((size_t)l * 64 + (kk - 64)) * 512 + ch]; }
            else if (grp == 2) { if (kk >= 128 && kk < 256) x = a->in[15][((size_t)l * 128 + (kk - 128)) * 512 + ch]; }
            else { if (l > 0 && kk >= 256 && kk < 288) x = a->in[22][((size_t)(l - 1) * 32 + (kk - 256)) * 512 + ch]; }
            v[e] = x; }
        v4u o; o.x = pk2(v[0], v[1]); o.y = pk2(v[2], v[3]); o.z = pk2(v[4], v[5]); o.w = pk2(v[6], v[7]);
        *(v4u*)(wl + (size_t)n * 384 + kc * 8) = o; }
}
__device__ __forceinline__ void phase_norm(const float* x32, const bf16* h16, const float* g, const float* modl, int i3, bf16* nout, int gw, int NGW, int lane) {
#pragma unroll 2
    for (int m = gw; m < M; m += NGW) { const int b = m >> 12; const float* sh = modl + (size_t)b * 9216 + (3 * i3) * 1024; const float* sc = sh + 1024;
        float v[2][8]; float ss = 0.f;
#pragma unroll
        for (int j = 0; j < 2; ++j) { const int col = 8 * lane + 512 * j;
            if (x32) { const f32x4 a0 = *(const f32x4*)(x32 + (size_t)m * D + col), a1 = *(const f32x4*)(x32 + (size_t)m * D + col + 4);
#pragma unroll
                for (int e = 0; e < 4; ++e) { v[j][e] = a0[e]; v[j][e + 4] = a1[e]; } }
            else unpack8(*(const v4u*)(h16 + (size_t)m * D + col), v[j]);
#pragma unroll
            for (int e = 0; e < 8; ++e) ss += v[j][e] * v[j][e]; }
        const float rstd = __builtin_amdgcn_rsqf(wave_sum(ss, lane) * (1.f / D) + 1e-6f);
#pragma unroll
        for (int j = 0; j < 2; ++j) { const int col = 8 * lane + 512 * j; float y[8];
            const f32x4 g0 = *(const f32x4*)(g + col), g1 = *(const f32x4*)(g + col + 4), s0 = *(const f32x4*)(sc + col), s1 = *(const f32x4*)(sc + col + 4), h0 = *(const f32x4*)(sh + col), h1 = *(const f32x4*)(sh + col + 4);
#pragma unroll
            for (int e = 0; e < 4; ++e) { y[e] = v[j][e] * rstd * g0[e] * (1.f + s0[e]) + h0[e]; y[e + 4] = v[j][e + 4] * rstd * g1[e] * (1.f + s1[e]) + h1[e]; }
            *(v4u*)(nout + (size_t)m * D + col) = packarr(y); } }
}
__device__ __forceinline__ void unpack8(const v4u q, float* x) { x[0] = bflo(q.x); x[1] = bfhi(q.x); x[2] = bflo(q.y); x[3] = bfhi(q.y); x[4] = bflo(q.z); x[5] = bfhi(q.z); x[6] = bflo(q.w); x[7] = bfhi(q.w); }
__device__ __forceinline__ v4u packarr(const float* x) { v4u o; o.x = pk2(x[0], x[1]); o.y = pk2(x[2], x[3]); o.z = pk2(x[4], x[5]); o.w = pk2(x[6], x[7]); return o; }
__device__ __forceinline__ void phase_prep(CArgs a, int l, int gw, int NGW, int lane, const bool do_qk = true) {
    unsigned char* ws = a->ws;
    const bf16* prw = (const bf16*)(ws + WS_PRW);
    bf16 *R = (bf16*)(ws + WS_R), *KM = (bf16*)(ws + WS_KM), *KK = (bf16*)(ws + WS_KK), *VV = (bf16*)(ws + WS_VV), *VF = (bf16*)(ws + WS_VFIRST), *AL = (bf16*)(ws + WS_ALORA);
    const float* mu = a->in[10] + (size_t)l * 1792; const float* kkw = a->in[16] + (size_t)l * 512;
    const v4u z4 = (v4u){0u, 0u, 0u, 0u};
#pragma unroll 2
    for (int m = gw; m < M; m += NGW) { const int s = m & 4095, b = m >> 12; const bool hp = s != 0;
        const bf16* cur = prw + (size_t)m * PRW_LD; const bf16* prv = cur - PRW_LD;
#pragma unroll
        for (int i = 0; i < 3; ++i) { const int col = (lane + 64 * i) * 8; float c[8], p[8], x[8];
            unpack8(*(const v4u*)(cur + col), c); unpack8(hp ? *(const v4u*)(prv + col) : z4, p);
            const f32x4 m0 = *(const f32x4*)(mu + col), m1 = *(const f32x4*)(mu + col + 4);
#pragma unroll
            for (int e = 0; e < 4; ++e) { x[e] = c[e] + (p[e] - c[e]) * m0[e]; x[e + 4] = c[e + 4] + (p[e + 4] - c[e + 4]) * m1[e]; }
            const size_t off = (size_t)m * RW + lane * 8;
            if (i == 0) *(v4u*)(R + off) = packarr(x);
            else if (i == 1) { *(v4u*)(KM + off) = packarr(x); const f32x4 k0 = *(const f32x4*)(kkw + lane * 8), k1 = *(const f32x4*)(kkw + lane * 8 + 4); float ss = 0.f;
#pragma unroll
                for (int e = 0; e < 4; ++e) { x[e] *= k0[e]; x[e + 4] *= k1[e]; ss += x[e] * x[e] + x[e + 4] * x[e + 4]; }
                ss += SHX(ss, 1); ss += SHX(ss, 2); ss += SHX(ss, 4);
                const float inv = fminf(__builtin_amdgcn_rsqf(ss), 1e12f);
#pragma unroll
                for (int e = 0; e < 8; ++e) x[e] *= inv;
                *(v4u*)(KK + off) = packarr(x); }
            else { const v4u o = packarr(x); *(v4u*)(VV + off) = o; if (l == 0) *(v4u*)(VF + off) = o; } }
        if (lane < 48) { float x[8];
            if (lane < 32) { const int col = 1536 + lane * 8; float c[8], p[8];
                unpack8(*(const v4u*)(cur + col), c); unpack8(hp ? *(const v4u*)(prv + col) : z4, p);
#pragma unroll
                for (int e = 0; e < 8; ++e) { const float xx = c[e] + (p[e] - c[e]) * mu[col + e];
                    x[e] = lane < 8 ? (1.f - 2.f * __builtin_amdgcn_rcpf(fexp(2.f * xx) + 1.f)) : (lane < 16 ? xx : sigmoidf_(xx)); } }
            else if (lane < 36 && l > 0) { unpack8(*(const v4u*)(cur + 1792 + (lane - 32) * 8), x); }
            else {
#pragma unroll
                for (int e = 0; e < 8; ++e) x[e] = 0.f; }
            *(v4u*)(AL + (size_t)m * 384 + lane * 8) = packarr(x); }
    }
}
constexpr int SC_T = 32, SC_NP = 16, SC_VEC = 0, SC_SCAL = 9216, SC_V = 9280, SC_BUFF = 9792, SC_BUF = SC_BUFF * 4, SC_YB = 2 * SC_BUF;
__device__ __forceinline__ f32x4 h4(const v2u q) { return (f32x4){bflo(q.x), bfhi(q.x), bflo(q.y), bfhi(q.y)}; }
__device__ __forceinline__ float dot4(const f32x4 a, const f32x4 b) { f32x2 t = (f32x2){a.x, a.y} * (f32x2){b.x, b.y}; t = (f32x2){a.z, a.w} * (f32x2){b.z, b.w} + t; return t.x + t.y; }
__device__ __forceinline__ void scan_unit(CArgs a, LAS unsigned char* lds, int l, int hh, int qq, int tid) {
    unsigned char* ws = a->ws;
    const int b = hh >> 3, h = hh & 7;
    constexpr int NC = S / SC_T;
    if (tid >= 256) {
        const int ht = tid - 256, hp = ht >> 4, hl = ht & 15;
        const size_t goff = ((size_t)b * S + 2 * hp) * RW + h * 64 + hl * 4;
        const bf16 *t0 = (const bf16*)(ws + WS_R) + goff, *t1 = (const bf16*)(ws + WS_WL2) + goff, *t2 = (const bf16*)(ws + WS_KM) + goff, *t3 = (const bf16*)(ws + WS_KK) + goff, *t4 = (const bf16*)(ws + WS_BB) + goff;
        const bf16* t5 = (const bf16*)(ws + WS_VV) + ((size_t)b * S + (ht >> 1)) * RW + h * 64 + 16 * qq + (ht & 1) * 8;
        const int ytok = ht >> 3, ypart = ht & 7;
        const f32x4 rkh = *(const f32x4*)(a->in[18] + l * 512 + h * 64 + hl * 4);
        float* bon = (float*)(ws + WS_BONUS) + (size_t)b * S * 8 + h;
        bf16* yo = (bf16*)(ws + WS_YA) + ((size_t)b * S + ytok) * RW + h * 64 + 16 * qq + 2 * ypart;
        v2u r0q, r1q, w0q, w1q, k0q, k1q, n0q, n1q, b0q, b1q; v4u vq = (v4u){0u, 0u, 0u, 0u};
#define SC_HLOAD(cc) { const size_t o2 = (size_t)(cc) * SC_T * RW; r0q = *(const v2u*)(t0 + o2); r1q = *(const v2u*)(t0 + o2 + RW); w0q = *(const v2u*)(t1 + o2); w1q = *(const v2u*)(t1 + o2 + RW); \
            k0q = *(const v2u*)(t2 + o2); k1q = *(const v2u*)(t2 + o2 + RW); n0q = *(const v2u*)(t3 + o2); n1q = *(const v2u*)(t3 + o2 + RW); b0q = *(const v2u*)(t4 + o2); b1q = *(const v2u*)(t4 + o2 + RW); \
            if (ht < 64) vq = *(const v4u*)(t5 + o2); }
#define SC_HSTORE(cc) { LAS float* B = (LAS float*)(lds + ((cc) & 1) * SC_BUF); LAS float* vb = B + (hp * 9) * 64 + hl * 4; \
            const f32x4 r0 = h4(r0q), r1 = h4(r1q), k0 = h4(k0q), k1 = h4(k1q), n0 = h4(n0q), n1 = h4(n1q), b0 = h4(b0q), b1 = h4(b1q); f32x4 w0 = h4(w0q), w1 = h4(w1q); \
            _Pragma("unroll") for (int e = 0; e < 4; ++e) { w0[e] = __builtin_amdgcn_exp2f(w0[e]); w1[e] = __builtin_amdgcn_exp2f(w1[e]); } \
            *(LAS f32x4*)(vb) = n0; *(LAS f32x4*)(vb + 64) = w0 * n1; *(LAS f32x4*)(vb + 128) = w0 * w1; *(LAS f32x4*)(vb + 192) = b0 * w1; *(LAS f32x4*)(vb + 256) = k0 * w1; \
            *(LAS f32x4*)(vb + 320) = b1; *(LAS f32x4*)(vb + 384) = k1; *(LAS f32x4*)(vb + 448) = w0 * r0; *(LAS f32x4*)(vb + 512) = r1; \
            const float c1 = -red16(dot4(b0, n1)), c2 = -red16(dot4(k0, n1)), c3 = red16(dot4(b0, r0)), c4 = red16(dot4(k0, r0)); \
            if (hl == 0) *(LAS f32x4*)(B + SC_SCAL + hp * 4) = (f32x4){c1, c2, c3, c4}; \
            if (qq == 0) { const float bs0 = red16(dot4(r0 * k0, rkh)), bs1 = red16(dot4(r1 * k1, rkh)); if (hl == 0) { bon[((size_t)(cc) * SC_T + 2 * hp) * 8] = bs0; bon[((size_t)(cc) * SC_T + 2 * hp + 1) * 8] = bs1; } } \
            if (ht < 64) { float x[8]; unpack8(vq, x); const int vt = ht >> 1; LAS float* d = B + SC_V + ((vt >> 1) * 16 + (ht & 1) * 8) * 2 + (vt & 1); \
                _Pragma("unroll") for (int e = 0; e < 8; ++e) d[2 * e] = x[e]; } }
#define SC_HBAR() { asm volatile("s_waitcnt lgkmcnt(0)" ::: "memory"); __builtin_amdgcn_s_barrier(); asm volatile("" ::: "memory"); }
        SC_HLOAD(0); SC_HSTORE(0); SC_HLOAD(1);
        SC_HBAR();
        for (int c = 0; c < NC; ++c) {
            if (c + 1 < NC) SC_HSTORE(c + 1);
            if (c + 2 < NC) SC_HLOAD(c + 2);
            if (c >= 1) { LAS const float* yb = (LAS const float*)(lds + SC_YB + ((c - 1) & 1) * 2048) + ytok * 16 + 2 * ypart; *(unsigned*)(yo + (size_t)(c - 1) * SC_T * RW) = pk2(yb[0], yb[1]); }
            SC_HBAR();
        }
#undef SC_HLOAD
#undef SC_HSTORE
#undef SC_HBAR
        { LAS const float* yb = (LAS const float*)(lds + SC_YB + ((NC - 1) & 1) * 2048) + ytok * 16 + 2 * ypart; *(unsigned*)(yo + (size_t)(NC - 1) * SC_T * RW) = pk2(yb[0], yb[1]); }
    } else {
        const int row = tid >> 4, ks = tid & 15;
        f32x4 s0 = (f32x4){0.f, 0.f, 0.f, 0.f};
        __syncthreads();
        for (int c = 0; c < NC; ++c) {
            LAS const float* B0 = (LAS const float*)(lds + (c & 1) * SC_BUF);
            LAS float* yb = (LAS float*)(lds + SC_YB + (c & 1) * 2048);
#define SC_LD(P, j_) { const int jl = (j_) < SC_NP ? (j_) : SC_NP - 1; LAS const float* vb = B0 + (jl * 9) * 64 + 4 * ks; \
                P##0 = *(LAS const f32x4*)(vb); P##1 = *(LAS const f32x4*)(vb + 64); P##2 = *(LAS const f32x4*)(vb + 128); P##3 = *(LAS const f32x4*)(vb + 192); P##4 = *(LAS const f32x4*)(vb + 256); \
                P##5 = *(LAS const f32x4*)(vb + 320); P##6 = *(LAS const f32x4*)(vb + 384); P##7 = *(LAS const f32x4*)(vb + 448); P##8 = *(LAS const f32x4*)(vb + 512); \
                P##c = *(LAS const f32x4*)(B0 + SC_SCAL + jl * 4); P##v = *(LAS const f32x2*)(B0 + SC_V + (jl * 16 + row) * 2); }
#define SC_STEP(P, j_) { const float d0 = red16(dot4(s0, P##0)), e1 = red16(dot4(s0, P##1)), g0 = red16(dot4(s0, P##7)); \
                const float sa0 = -d0, sa1 = (sa0 * P##c.x + P##v.x * P##c.y) - e1, y0 = g0 + (sa0 * P##c.z + P##v.x * P##c.w); \
                s0 = s0 * P##2 + (sa0 * P##3 + P##v.x * P##4) + (sa1 * P##5 + P##v.y * P##6); \
                const float y1 = red16(dot4(s0, P##8)); \
                if (ks == 0) { yb[(2 * (j_)) * 16 + row] = y0; yb[(2 * (j_) + 1) * 16 + row] = y1; } }
            f32x4 A0, A1, A2, A3, A4, A5, A6, A7, A8, Ac, B_0, B_1, B_2, B_3, B_4, B_5, B_6, B_7, B_8, B_c; f32x2 Av, B_v;
            SC_LD(A, 0); SC_LD(B_, 1);
#pragma unroll 2
            for (int j = 0; j < SC_NP; j += 2) {
                SC_STEP(A, j); SC_LD(A, j + 2);
                SC_STEP(B_, j + 1); SC_LD(B_, j + 3);
            }
#undef SC_LD
#undef SC_STEP
            __syncthreads();
        }
    }
    __syncthreads();
}
__device__ __forceinline__ void phase_scanfin(CArgs a, int l, int gw, int NGW, int lane, const bool do_store = true) {
    unsigned char* ws = a->ws;
    bf16* YA = (bf16*)(ws + WS_YA); const bf16 *VV = (const bf16*)(ws + WS_VV), *GG = (const bf16*)(ws + WS_GG); const float* BON = (const float*)(ws + WS_BONUS);
    const int ch = lane * 8;
    float lw[8], lb[8];
#pragma unroll
    for (int e = 0; e < 8; ++e) { lw[e] = a->in[19][l * 512 + ch + e]; lb[e] = a->in[20][l * 512 + ch + e]; }
#pragma unroll 2
    for (int m = gw; m < M; m += NGW) { const size_t off = (size_t)m * RW + ch; float y[8], v[8], g[8];
        unpack8(*(const v4u*)(YA + off), y); unpack8(*(const v4u*)(VV + off), v); unpack8(*(const v4u*)(GG + off), g);
        const float bs = BON[(size_t)m * 8 + (lane >> 3)];
        float s1 = 0.f;
#pragma unroll
        for (int e = 0; e < 8; ++e) s1 += y[e];
        s1 += SHX(s1, 1); s1 += SHX(s1, 2); s1 += SHX(s1, 4);
        const float mean = s1 * (1.f / 64.f); float s2 = 0.f;
#pragma unroll
        for (int e = 0; e < 8; ++e) { y[e] -= mean; s2 += y[e] * y[e]; }
        s2 += SHX(s2, 1); s2 += SHX(s2, 2); s2 += SHX(s2, 4);
        const float rstd = __builtin_amdgcn_rsqf(s2 * (1.f / 64.f) + 64e-5f);
#pragma unroll
        for (int e = 0; e < 8; ++e) y[e] = (y[e] * rstd * lw[e] + lb[e] + bs * v[e]) * g[e];
        if (do_store || y[0] == 12345.678f) *(v4u*)(YA + off) = packarr(y); }
}
constexpr int AT_BUF = 18432, AT_LDK = 72;
constexpr float AT_EXIT = 64.f;
__device__ __forceinline__ float softplus2(float z) { return fmaxf(z, 0.f) + __builtin_amdgcn_logf(1.f + __builtin_amdgcn_exp2f(-fabsf(z))); }
__device__ __forceinline__ void attn_unit(CArgs a, LAS unsigned char* lds, int l, int bh, int qb, int tid, int wave, int lane) {
    unsigned char* ws = a->ws;
    const bf16* Q = (const bf16*)(ws + WS_Q) + (size_t)bh * S * HD; const bf16* K = (const bf16*)(ws + WS_K) + (size_t)bh * S * HD; const bf16* VT = (const bf16*)(ws + WS_VT) + (size_t)bh * HD * S;
    bf16* YB = (bf16*)(ws + WS_YB);
    const int ql = lane & 31, hi = lane >> 5, qr0 = qb * 256 + wave * 32, qabs = qr0 + ql;
    bf16x8 qf[4];
    {
        const float* qg = a->in[23] + l * 64; float xq[4][8]; float ss = 0.f;
#pragma unroll
        for (int ds = 0; ds < 4; ++ds) { unpack8(*(const v4u*)(Q + (size_t)qabs * HD + 16 * ds + 8 * hi), xq[ds]);
#pragma unroll
            for (int e = 0; e < 8; ++e) ss += xq[ds][e] * xq[ds][e]; }
        const auto rr = __builtin_amdgcn_permlane32_swap(__float_as_uint(ss), __float_as_uint(ss), false, false);
        const float rstd = __builtin_amdgcn_rsqf((__uint_as_float(rr[0]) + __uint_as_float(rr[1])) * (1.f / 64.f) + 1e-6f) * (0.125f * LOG2E);
#pragma unroll
        for (int ds = 0; ds < 4; ++ds) {
#pragma unroll
            for (int e = 0; e < 8; ++e) xq[ds][e] *= rstd * qg[16 * ds + 8 * hi + e];
            qf[ds] = __builtin_bit_cast(bf16x8, packarr(xq[ds])); } }
    f32x16 o0, o1;
#pragma unroll
    for (int r = 0; r < 16; ++r) { o0[r] = 0.f; o1[r] = 0.f; }
    float L = 0.f; float wmin = 0.f;
    const int srow = tid >> 3, spart = tid & 7;
    const f32x4 kg0 = *(const f32x4*)(a->in[24] + l * 64 + spart * 8), kg1 = *(const f32x4*)(a->in[24] + l * 64 + spart * 8 + 4);
#define AT_KNORM(kq_) { float xk[8]; unpack8(kq_, xk); float ss = 0.f; _Pragma("unroll") for (int e = 0; e < 8; ++e) ss += xk[e] * xk[e]; \
        ss += SHX(ss, 1); ss += SHX(ss, 2); ss += SHX(ss, 4); const float rs_ = __builtin_amdgcn_rsqf(ss * (1.f / 64.f) + 1e-6f); \
        _Pragma("unroll") for (int e = 0; e < 4; ++e) { xk[e] *= rs_ * kg0[e]; xk[e + 4] *= rs_ * kg1[e]; } kq_ = packarr(xk); }
    LAS float* lmin = (LAS float*)(lds + MISC_OFF + 64);
    int kt = qb * 4 + 3;
    v4u kq = *(const v4u*)(K + (size_t)(64 * kt + srow) * HD + spart * 8), vq = *(const v4u*)(VT + (size_t)srow * S + 64 * kt + spart * 8);
    AT_KNORM(kq);
    *(LAS v4u*)(lds + srow * (AT_LDK * 2) + spart * 16) = kq; *(LAS v4u*)(lds + 9216 + srow * (AT_LDK * 2) + spart * 16) = vq;
    __syncthreads();
    int cur = 0;
    for (; kt >= 0; --kt) {
        if (kt > 0) { kq = *(const v4u*)(K + (size_t)(64 * (kt - 1) + srow) * HD + spart * 8); vq = *(const v4u*)(VT + (size_t)srow * S + 64 * (kt - 1) + spart * 8); }
        LAS const unsigned char* Ks = lds + cur * AT_BUF; LAS const unsigned char* Vs = Ks + 9216;
        if (64 * kt < qr0 + 31 && wmin <= AT_EXIT) {
            f32x16 p0, p1;
#pragma unroll
            for (int r = 0; r < 16; ++r) { p0[r] = 0.f; p1[r] = 0.f; }
#pragma unroll
            for (int ds = 0; ds < 4; ++ds) { const bf16x8 k0 = *(LAS const bf16x8*)(Ks + ql * (AT_LDK * 2) + ds * 32 + hi * 16), k1 = *(LAS const bf16x8*)(Ks + (32 + ql) * (AT_LDK * 2) + ds * 32 + hi * 16);
                p0 = __builtin_amdgcn_mfma_f32_32x32x16_f16(__builtin_bit_cast(h16x8, k0), __builtin_bit_cast(h16x8, qf[ds]), p0, 0, 0, 0); p1 = __builtin_amdgcn_mfma_f32_32x32x16_f16(__builtin_bit_cast(h16x8, k1), __builtin_bit_cast(h16x8, qf[ds]), p1, 0, 0, 0); }
            const bool need_mask = (64 * kt + 63 >= qr0);
            f32x16 sp0, sp1;
#pragma unroll
            for (int r = 0; r < 16; ++r) { const int kl = (r & 3) + 8 * (r >> 2) + 4 * hi; float a0 = softplus2(p0[r]), a1 = softplus2(p1[r]);
                p0[r] -= a0; p1[r] -= a1;
                if (need_mask) { if (64 * kt + kl >= qabs) { a0 = 0.f; p0[r] = -1e30f; } if (64 * kt + 32 + kl >= qabs) { a1 = 0.f; p1[r] = -1e30f; } }
                sp0[r] = a0; sp1[r] = a1; }
            float off[8]; float run = 0.f;
#pragma unroll
            for (int g = 7; g >= 0; --g) { const float gs = g < 4 ? (sp0[4 * g] + sp0[4 * g + 1]) + (sp0[4 * g + 2] + sp0[4 * g + 3]) : (sp1[4 * g - 16] + sp1[4 * g - 15]) + (sp1[4 * g - 14] + sp1[4 * g - 13]);
                const auto rr = __builtin_amdgcn_permlane32_swap(__float_as_uint(gs), __float_as_uint(gs), false, false);
                const float x0 = __uint_as_float(rr[0]), x1 = __uint_as_float(rr[1]);
                off[g] = run + (hi ? 0.f : x1);
                run += x0 + x1; }
            bf16x8 pf[4];
#pragma unroll
            for (int g = 0; g < 8; ++g) { float e3, e2, e1, e0;
                if (g < 4) { e3 = off[g] + L; e2 = e3 + sp0[4 * g + 3]; e1 = e2 + sp0[4 * g + 2]; e0 = e1 + sp0[4 * g + 1];
                    const float w0 = __builtin_amdgcn_exp2f(p0[4 * g] - e0), w1 = __builtin_amdgcn_exp2f(p0[4 * g + 1] - e1), w2 = __builtin_amdgcn_exp2f(p0[4 * g + 2] - e2), w3 = __builtin_amdgcn_exp2f(p0[4 * g + 3] - e3);
                    const unsigned u0 = pk2(w0, w1), u1 = pk2(w2, w3); const int j = g >> 1, e = (g & 1) * 4;
                    pf[j][e] = (short)(u0 & 0xffff); pf[j][e + 1] = (short)(u0 >> 16); pf[j][e + 2] = (short)(u1 & 0xffff); pf[j][e + 3] = (short)(u1 >> 16); }
                else { const int gg = g - 4; e3 = off[g] + L; e2 = e3 + sp1[4 * gg + 3]; e1 = e2 + sp1[4 * gg + 2]; e0 = e1 + sp1[4 * gg + 1];
                    const float w0 = __builtin_amdgcn_exp2f(p1[4 * gg] - e0), w1 = __builtin_amdgcn_exp2f(p1[4 * gg + 1] - e1), w2 = __builtin_amdgcn_exp2f(p1[4 * gg + 2] - e2), w3 = __builtin_amdgcn_exp2f(p1[4 * gg + 3] - e3);
                    const unsigned u0 = pk2(w0, w1), u1 = pk2(w2, w3); const int j = g >> 1, e = (g & 1) * 4;
                    pf[j][e] = (short)(u0 & 0xffff); pf[j][e + 1] = (short)(u0 >> 16); pf[j][e + 2] = (short)(u1 & 0xffff); pf[j][e + 3] = (short)(u1 >> 16); } }
            L += run;
#pragma unroll
            for (int j = 0; j < 4; ++j) {
                const v2u a00 = *(LAS const v2u*)(Vs + ql * (AT_LDK * 2) + (16 * j + 4 * hi) * 2), a01 = *(LAS const v2u*)(Vs + ql * (AT_LDK * 2) + (16 * j + 8 + 4 * hi) * 2);
                const v2u a10 = *(LAS const v2u*)(Vs + (32 + ql) * (AT_LDK * 2) + (16 * j + 4 * hi) * 2), a11 = *(LAS const v2u*)(Vs + (32 + ql) * (AT_LDK * 2) + (16 * j + 8 + 4 * hi) * 2);
                const v4u A0 = (v4u){a00.x, a00.y, a01.x, a01.y}, A1 = (v4u){a10.x, a10.y, a11.x, a11.y};
                o0 = __builtin_amdgcn_mfma_f32_32x32x16_f16(__builtin_bit_cast(h16x8, A0), __builtin_bit_cast(h16x8, pf[j]), o0, 0, 0, 0);
                o1 = __builtin_amdgcn_mfma_f32_32x32x16_f16(__builtin_bit_cast(h16x8, A1), __builtin_bit_cast(h16x8, pf[j]), o1, 0, 0, 0); }
        }
        float wm = L;
#pragma unroll
        for (int o = 1; o < 64; o <<= 1) wm = fminf(wm, SHX(wm, o));
        wmin = wm;
        if (lane == 0) lmin[wave] = wm;
        __syncthreads();
        float bm = lmin[0];
#pragma unroll
        for (int w = 1; w < 8; ++w) bm = fminf(bm, lmin[w]);
        if (bm > AT_EXIT || kt == 0) break;
        cur ^= 1;
        AT_KNORM(kq);
        *(LAS v4u*)(lds + cur * AT_BUF + srow * (AT_LDK * 2) + spart * 16) = kq; *(LAS v4u*)(lds + cur * AT_BUF + 9216 + srow * (AT_LDK * 2) + spart * 16) = vq;
        __syncthreads();
    }
    const int b = bh >> 3, h = bh & 7;
    bf16* yrow = YB + ((size_t)b * S + qabs) * RW + h * 64;
#pragma unroll
    for (int g = 0; g < 4; ++g) { v2u w; w.x = pk2(o0[4 * g], o0[4 * g + 1]); w.y = pk2(o0[4 * g + 2], o0[4 * g + 3]); *(v2u*)(yrow + 8 * g + 4 * hi) = w;
        w.x = pk2(o1[4 * g], o1[4 * g + 1]); w.y = pk2(o1[4 * g + 2], o1[4 * g + 3]); *(v2u*)(yrow + 32 + 8 * g + 4 * hi) = w; }
    __syncthreads();
}
__device__ __forceinline__ void phase_mixer(CArgs a, LAS unsigned char* lds, int l, const int wave_s) {
    unsigned* ctr = (unsigned*)(a->ws + WS_CTL) + 64 * l; l &= 3;
    volatile LAS unsigned* qw = (volatile LAS unsigned*)(lds + MISC_OFF);
#ifdef PROBE_ATT2
    constexpr int NU = 256 + 2 * 64 * 16;
#else
    constexpr int NU = 256 + 64 * 16;
#endif
    for (;;) {
        const int lane = fresh_lane(), wave = wave_s, tid = wave * 64 + lane;
        if (tid == 0) qw[0] = atomicAdd(ctr, 1u);
        __syncthreads();
        const int u = (int)qw[0];
        __syncthreads();
        if (u >= NU) break;
        if (u < 256) scan_unit(a, lds, l, u >> 2, u & 3, tid);
        else { const int v = (u - 256) & 1023; attn_unit(a, lds, l, v & 63, 15 - (v >> 6), tid, wave, lane); }
    }
}
#define XB_TMO      128
#define XB_XCNT(j)  (256  + 64 * (j))
#define XB_XSUB(j)  (1280 + 64 * (j))
#define XB_XGEN(j)  (2304 + 64 * (j))
#define XB_TOP      3328
#define XB_TOPGEN   3392
#define XCD_BAR_WORDS 3456
#define XB_SPIN_CAP (1u << 18)
constexpr int BAR_WORD0 = 16384;
__device__ __forceinline__ unsigned xb_ld(unsigned* p)              { return __hip_atomic_load(p, __ATOMIC_RELAXED, __HIP_MEMORY_SCOPE_AGENT); }
__device__ __forceinline__ unsigned xb_add(unsigned* p, unsigned v) { return __hip_atomic_fetch_add(p, v, __ATOMIC_RELAXED, __HIP_MEMORY_SCOPE_AGENT); }
__device__ __forceinline__ unsigned xb_xcc_id() { return (unsigned)__builtin_amdgcn_s_getreg((3 << 11) | 20) & 0xFu; }
#define XB_SPIN(cond, bar) do { unsigned _sp = 0; while (cond) { __builtin_amdgcn_s_sleep(1); \
    if ((++_sp & 255u) == 0u) { if (xb_ld(&(bar)[XB_TMO])) break; if (_sp > XB_SPIN_CAP) { atomicAdd(&(bar)[XB_TMO], 1u); break; } } } } while (0)
__device__ __forceinline__ void xcd_barrier_complete(unsigned* bar, unsigned x, unsigned& nloc, unsigned& nx) {
    const unsigned G = gridDim.x * gridDim.y * gridDim.z;
    unsigned sum, cnt, mine, sp = 0u;
    for (;;) {
        sum = 0u; cnt = 0u; mine = 0u;
#pragma unroll
        for (unsigned j = 0; j < 16; ++j) { const unsigned c = xb_ld(&bar[XB_XCNT(j)]); sum += c; cnt += (c > 0u) ? 1u : 0u; mine = (j == x) ? c : mine; }
        if (sum == G) break;
        __builtin_amdgcn_s_sleep(1);
        if ((++sp & 255u) == 0u) { if (xb_ld(&bar[XB_TMO])) break; if (sp > XB_SPIN_CAP) { atomicAdd(&bar[XB_TMO], 1u); break; } }
    }
    nloc = mine > 0u ? mine : 1u; nx = cnt > 0u ? cnt : 1u;
}
__device__ __forceinline__ void grid_barrier(unsigned* ctl, LAS unsigned char* lds, const int wave_s) {
    asm volatile("s_waitcnt vmcnt(0) lgkmcnt(0)" ::: "memory");
    __syncthreads();
    if (wave_s * 64 + fresh_lane() == 0) {
        unsigned* bar = ctl + BAR_WORD0; volatile LAS unsigned* st = (volatile LAS unsigned*)(lds + MISC_OFF + 128);
        const unsigned x = xb_xcc_id();
        __builtin_amdgcn_s_waitcnt(0);
        unsigned nloc = st[0], nx = st[1];
        if (nloc == 0u) { xcd_barrier_complete(bar, x, nloc, nx); st[0] = nloc; st[1] = nx; }
        const unsigned old = xb_add(&bar[XB_XSUB(x)], 1u);
        const unsigned gen = old / nloc;
        if (old + 1u == (gen + 1u) * nloc) {
            __builtin_amdgcn_fence(__ATOMIC_RELEASE, "agent");
            asm volatile("s_waitcnt vmcnt(0)" ::: "memory");
            const unsigned og = xb_add(&bar[XB_TOP], 1u);
            const unsigned tg = og / nx;
            if (og + 1u == (tg + 1u) * nx) xb_add(&bar[XB_TOPGEN], 1u);
            else XB_SPIN(xb_ld(&bar[XB_TOPGEN]) == tg, bar);
            __builtin_amdgcn_fence(__ATOMIC_ACQUIRE, "agent");
            xb_add(&bar[XB_XGEN(x)], 1u);
            asm volatile("s_waitcnt vmcnt(0)" ::: "memory");
        } else {
            XB_SPIN(xb_ld(&bar[XB_XGEN(x)]) == gen, bar);
            __builtin_amdgcn_fence(__ATOMIC_ACQUIRE, "agent");
            asm volatile("s_waitcnt vmcnt(0)" ::: "memory");
        }
    }
    __syncthreads();
}
__global__ void __launch_bounds__(512, 2) mk_fwd(Args a) {
    extern __shared__ __attribute__((aligned(16))) unsigned char lds_raw[];
    LAS unsigned char* lds = (LAS unsigned char*)lds_raw;
    cg::grid_group grid = cg::this_grid();
    const int wave_k = __builtin_amdgcn_readfirstlane((int)threadIdx.x >> 6);
    { const int t0 = wave_k * 64 + fresh_lane(); if (t0 < 2) ((volatile LAS unsigned*)(lds + MISC_OFF + 128))[t0] = 0u;
      if (t0 == 0) (void)xb_add((unsigned*)(a.ws + WS_CTL) + BAR_WORD0 + XB_XCNT(xb_xcc_id()), 1u); }
    __syncthreads();
    grid.sync();
    unsigned bar_round = 0;
    const int ph_lo = a.ph_lo, ph_hi = a.ph_hi;
    for (int ph = ph_lo; ph < ph_hi; ++ph) {
        int bid = blockIdx.x; asm volatile("" : "+s"(bid));
        int wave_s = wave_k; asm volatile("" : "+s"(wave_s));
#define FRESH_TID() const int lane = fresh_lane(), wave = wave_s, tid = wave * 64 + lane, gw = bid * 8 + wave; (void)tid; (void)gw
        CArgs ap = (CArgs)__builtin_amdgcn_kernarg_segment_ptr(); asm volatile("" : "+s"(ap));
        const int G = gridDim.x, NGW = G * 8;
        unsigned char* ws = ap->ws;
        const float* mod = (const float*)(ws + WS_MOD);
        if (ph == 0) {
#ifndef SK_MOD
            FRESH_TID(); phase_mod(ap, lds, tid, bid, G);
#ifdef PROBE_THIN2
            __syncthreads(); phase_mod(ap, lds, tid, bid, G);
#endif
#endif
        }
        else {
            const int l = (ph - 1) / NPH_LAYER, idx = (ph - 1) % NPH_LAYER;
            const float* modl = mod + (size_t)l * 8 * 9216;
            if (0) {}
#ifndef SK_NORM
            else if (idx == 0 || idx == 3 || idx == 11) {
                FRESH_TID();
                if (idx == 0) phase_convert(ap, lds, l, gw, NGW, wave, lane, bid * 512 + tid, G * 512);
#ifdef PROBE_CONV2
                if (idx == 0) { __syncthreads(); phase_convert(ap, lds, l, gw, NGW, wave, lane, bid * 512 + tid, G * 512); }
#endif
                const int i3 = idx == 0 ? 0 : (idx == 3 ? 1 : 2);
                phase_norm((l == 0 && idx == 0) ? ap->in[0] : nullptr, (const bf16*)(ws + WS_H16), ap->in[4] + (size_t)(l * 3 + i3) * 1024, modl, i3, (bf16*)(ws + WS_N), gw, NGW, lane);
#ifdef PROBE_NORM2
                phase_norm((l == 0 && idx == 0) ? ap->in[0] : nullptr, (const bf16*)(ws + WS_H16), ap->in[4] + (size_t)(l * 3 + i3) * 1024, modl, i3, (bf16*)(ws + WS_N), gw, NGW, lane);
#endif
            }
#endif
#ifndef SK_G1
            else if (idx == 1 || idx == 12) {
                pg8::Gemm g{(const pg8::bf16_t*)(ws + WS_N), (const pg8::bf16_t*)(ws + (idx == 1 ? WS_WG1 : WS_WG1B)), M, 2 * FF, D}; pg8::StaticOrder So; So.init(M, 2 * FF, G, bid);
                EpiSwiglu E{(bf16*)(ws + WS_ACT)};
                pg8::gemm_phase<EpiSwiglu, pg8::StaticOrder, true, true>(lds, g, So, E, wave_s);
#ifdef PROBE_G1X2
                __syncthreads(); pg8::gemm_phase<EpiSwiglu, pg8::StaticOrder, true, true>(lds, g, So, E, wave_s);
#endif
#ifdef PROBE_G1X2B
                ++bar_round; grid_barrier((unsigned*)(ap->ws + WS_CTL), lds, wave_s);
                pg8::gemm_phase<EpiSwiglu, pg8::StaticOrder, true, true>(lds, g, So, E, wave_s);
#endif
            }
#endif
#ifndef SK_G2
            else if (idx == 2 || idx == 10 || idx == 13) {
                const bf16* A = (const bf16*)(ws + (idx == 10 ? WS_MERGED : WS_ACT)); const bf16* Bt = (const bf16*)(ws + (idx == 2 ? WS_WG2 : (idx == 10 ? WS_WOUT : WS_WG2B)));
                pg8::Gemm g{A, Bt, M, D, idx == 10 ? D : FF}; pg8::StaticOrder So; So.init(M, D, G, bid);
                EpiResid E{ap, l, idx};
#ifdef PROBE_G2NULL
                { EpiNull En{(float*)(ws + WS_CTL) + 900}; pg8::gemm_phase<EpiNull, pg8::StaticOrder, true, true>(lds, g, So, En, wave_s); __syncthreads(); }
#endif
                pg8::gemm_phase<EpiResid, pg8::StaticOrder, true, true>(lds, g, So, E, wave_s);
            }
#endif
#ifndef SK_IN
            else if (idx == 4) {
                const int nn = l == 0 ? 5376 : 5632;
                pg8::Gemm g{(const bf16*)(ws + WS_N), (const bf16*)(ws + WS_WIN), M, nn, D}; pg8::StaticOrder So; So.init(M, nn, G, bid);
                EpiIn E{ws, ap->out};
                pg8::gemm_phase<EpiIn, pg8::StaticOrder, true, true>(lds, g, So, E, wave_s);
#ifdef PROBE_IN2
                __syncthreads(); pg8::gemm_phase<EpiIn, pg8::StaticOrder, true, true>(lds, g, So, E, wave_s);
#endif
#ifdef PROBE_ALLB
                ++bar_round; grid_barrier((unsigned*)(ap->ws + WS_CTL), lds, wave_s); pg8::gemm_phase<EpiIn, pg8::StaticOrder, true, true>(lds, g, So, E, wave_s);
#endif
            }
#endif
#ifndef SK_PREP
            else if (idx == 5) {
                FRESH_TID(); phase_prep(ap, l, gw, NGW, lane);
#ifdef PROBE_THIN2
                phase_prep(ap, l, gw, NGW, lane, false);
#endif
            }
#endif
#ifndef SK_LORA
            else if (idx == 6) {
                pg8::Gemm g{(const bf16*)(ws + WS_ALORA), (const bf16*)(ws + WS_WLORA), M, 2048, 384};
                OffOrder So; So.b.init(M, 512, G, bid);
                So.off = 0; { EpiLora<0> E{ap, l}; pg8::gemm_phase<EpiLora<0>, OffOrder, true, true>(lds, g, So, E, wave_s); } __syncthreads();
#ifdef PROBE_LORA2
                So.off = 0; { EpiLora<0> E{ap, l}; pg8::gemm_phase<EpiLora<0>, OffOrder, true, true>(lds, g, So, E, wave_s); } __syncthreads();
                So.off = 4; { EpiLora<2> E{ap, l}; pg8::gemm_phase<EpiLora<2>, OffOrder, true, true>(lds, g, So, E, wave_s); } __syncthreads();
#endif
                So.off = 2; { EpiLora<1> E{ap, l}; pg8::gemm_phase<EpiLora<1>, OffOrder, true, true>(lds, g, So, E, wave_s); } __syncthreads();
                So.off = 4; { EpiLora<2> E{ap, l}; pg8::gemm_phase<EpiLora<2>, OffOrder, true, true>(lds, g, So, E, wave_s); } __syncthreads();
                if (l > 0) { So.off = 6; EpiLora<3> E{ap, l}; pg8::gemm_phase<EpiLora<3>, OffOrder, true, true>(lds, g, So, E, wave_s); }
            }
#endif
#ifndef SK_MIX
            else if (idx == 7) {
                phase_mixer(ap, lds, l, wave_s);
#ifdef PROBE_MIX2
                ++bar_round; grid_barrier((unsigned*)(ap->ws + WS_CTL), lds, wave_s); phase_mixer(ap, lds, l + 4, wave_s);
#endif
            }
#endif
#ifndef SK_UP
            else if (idx == 8) { FRESH_TID();
#ifdef PROBE_THIN2
                phase_scanfin(ap, l, gw, NGW, lane, false);
#endif
                phase_scanfin(ap, l, gw, NGW, lane); }
            else if (idx == 9) {
#if defined(PROBE_UP2) || defined(PROBE_ALLB)
              for (int rep = 0; rep < 2; ++rep) {
#endif
                { pg8::Gemm g{(const bf16*)(ws + WS_YA), (const bf16*)(ws + WS_WUPA), M, D, RW}; pg8::StaticOrder So; So.init(M, D, G, bid);
                  EpiUp<0> E{ws, ap->out};
                  pg8::gemm_phase<EpiUp<0>, pg8::StaticOrder, true, true>(lds, g, So, E, wave_s); }
                __syncthreads();
                { pg8::Gemm g{(const bf16*)(ws + WS_YB), (const bf16*)(ws + WS_WUPB), M, D, RW}; pg8::StaticOrder So; So.init(M, D, G, bid);
                  EpiUp<1> E{ws, ap->out};
                  pg8::gemm_phase<EpiUp<1>, pg8::StaticOrder, true, true>(lds, g, So, E, wave_s); }
#ifdef PROBE_UP2
                __syncthreads(); }
#endif
#ifdef PROBE_ALLB
                if (rep == 0) { ++bar_round; grid_barrier((unsigned*)(ap->ws + WS_CTL), lds, wave_s); } }
#endif
            }
#endif
        }
        if (ph + 1 < ph_hi) { ++bar_round; grid_barrier((unsigned*)(ap->ws + WS_CTL), lds, wave_s); }
#ifdef PROBE_BAR2
        if (ph + 1 < ph_hi) { ++bar_round; grid_barrier((unsigned*)(ap->ws + WS_CTL), lds, wave_s); }
#endif
    }
}

extern "C" void kernel_launch(void* const* d_in, const int* in_sizes, int n_in, void* d_out, int out_size, void* d_ws, size_t ws_size, hipStream_t stream) {
    static int grid = 0;
    if (grid == 0) {
        if (n_in != 31 || out_size != M * D || ws_size < WS_END) { fprintf(stderr, "kernel_launch: unexpected shapes (n_in %d, out %d, ws %zu < %zu)\n", n_in, out_size, ws_size, (size_t)WS_END); grid = -1; return; }
        int dev = 0, cus = 0, per_cu = 0;
        hipGetDevice(&dev); hipDeviceGetAttribute(&cus, hipDeviceAttributeMultiprocessorCount, dev);
        hipFuncSetAttribute((const void*)mk_fwd, hipFuncAttributeMaxDynamicSharedMemorySize, LDS_BYTES);
        hipOccupancyMaxActiveBlocksPerMultiprocessor(&per_cu, (const void*)mk_fwd, 512, LDS_BYTES);
        (void)hipGetLastError();
        if (per_cu < 1) per_cu = 1;
        grid = cus * per_cu;
    }
    if (grid < 0) return;
    hipMemsetAsync((char*)d_ws + WS_CTL, 0, 131072, stream);
    Args a{};
    for (int i = 0; i < 31; ++i) a.in[i] = (const float*)d_in[i];
    a.out = (float*)d_out; a.ws = (unsigned char*)d_ws; a.ph_lo = 0; a.ph_hi = NPHASES;
    void* args[] = {&a};
    hipError_t e = hipLaunchCooperativeKernel((const void*)mk_fwd, dim3(grid), dim3(512), args, LDS_BYTES, stream);
    if (e != hipSuccess) fprintf(stderr, "cooperative launch failed: %s (grid %d)\n", hipGetErrorString(e), grid);
}
```

```cpp
#include <hip/hip_runtime.h>
#include <hip/hip_cooperative_groups.h>
#include <cstdio>
#include <cstdint>
namespace cg = cooperative_groups;
namespace pg8 {
#define PG8_LAS __attribute__((address_space(3)))
typedef unsigned short bf16_t;
typedef _Float16 pg8_h8 __attribute__((ext_vector_type(8)));
typedef short bf16x8 __attribute__((ext_vector_type(8)));
typedef float f32x4 __attribute__((ext_vector_type(4)));
typedef unsigned u32x4 __attribute__((ext_vector_type(4)));
constexpr int BM = 256, BK = 64, HALF = 128, HTB = HALF * BK * 2  , STAGE_BYTES = 8 * HTB, NXCD = 8, WGM = 8;

__host__ __device__ __forceinline__ int lds_byte(int r, int c) { const int st = (r >> 4) * 2 + (c >> 5), rr = r & 15, cc = c & 31, ob = rr * 64 + cc * 2; return st * 1024 + (ob ^ (((ob >> 9) & 1) << 5)); }
__host__ __device__ __forceinline__ void stage_rc(int b, int& R, int& C) { const int st = b / 1024, sb = b % 1024, swz = sb ^ (((sb >> 9) & 1) << 5); R = (st >> 1) * 16 + swz / 64; C = (st & 1) * 32 + (swz % 64) / 2; }
__host__ __device__ __forceinline__ int perm32(int rho) { const int n = rho >> 4, i = rho & 15; return 8 * (i >> 2) + 4 * n + (i & 3); }

struct Unit { int pm, pn; };
struct Gemm { const bf16_t* A; const bf16_t* Bt; int M, N, K; };

struct StaticOrder {
    int nM, nN, nwg, G, c, wgm;
    __host__ __device__ void init(int M, int N, int G_, int c_, int wgm_ = 4) { nM = M / BM; nN = N / BM; nwg = nM * nN; G = G_; c = c_; wgm = wgm_; }
    __host__ __device__ bool next(int i, Unit& u) const {
        const long L = (long)i * G + c; if (L >= nwg) return false;
        int wgid = (int)L; { const int q = nwg / NXCD, r = nwg % NXCD, xcd = wgid % NXCD, off = wgid / NXCD; wgid = (xcd < r ? xcd * (q + 1) : r * (q + 1) + (xcd - r) * q) + off; }
        const int nig = wgm * nN, gid = wgid / nig, fm = gid * wgm, gsz = (nM - fm) < wgm ? (nM - fm) : wgm;
        u.pm = fm + ((wgid % nig) % gsz); u.pn = (wgid % nig) / gsz; return true;
    }
    __device__ __forceinline__ void a_ready(const Unit&) const {}
    __device__ __forceinline__ void done(const Unit&) const {}
};

__device__ __forceinline__ unsigned cvt_pk_bf16(float lo, float hi) { unsigned r; asm volatile("v_cvt_pk_bf16_f32 %0, %1, %2" : "=v"(r) : "v"(lo), "v"(hi)); return r; }
template <class Epi, class Sched, bool ALIGN_EPI = false, bool SP2 = false>
__device__ __forceinline__ void gemm_phase(PG8_LAS unsigned char* lds, const Gemm g, const Sched& S, const Epi& E, const int wave_s) {
    int lane_; asm volatile("v_mbcnt_lo_u32_b32 %0, -1, 0\n\tv_mbcnt_hi_u32_b32 %0, -1, %0" : "=v"(lane_));
    const int wid = wave_s, lane = lane_, tid = wid * 64 + lane, wr = wid >> 2, wc = wid & 3, fr = lane & 15, fq = lane >> 4;
    const int K = g.K, nt = K / BK;
    unsigned voffA[2], voffB[2];
#pragma unroll
    for (int i = 0; i < 2; ++i) { int R, C; stage_rc(tid * 16 + i * 8192, R, C); const int Rb = Epi::PERM ? ((R & ~31) + perm32(R & 31)) : R;
        voffA[i] = (unsigned)(R * K + C) * 2u; voffB[i] = (unsigned)(Rb * K + C) * 2u; }
    const size_t kstep = (size_t)(BK * 2);
    const size_t hstep = (size_t)HALF * K * 2;
    const size_t tstep = 2 * hstep;
    const unsigned ldsw = (unsigned)wid * 1024u;
    const int aoff = lds_byte(wr * 64 + fr, fq * 8), boff = lds_byte(wc * 32 + fr, fq * 8);
#define PG8_SA(b, h) (((b) * 2 + (h)) * HTB)
#define PG8_SB(b, h) ((4 + (b) * 2 + (h)) * HTB)
#define PG8_STAGE(bufoff, gbase, voff) do { _Pragma("unroll") for (int _i = 0; _i < 2; ++_i) \
        __builtin_amdgcn_global_load_lds((const unsigned*)((const char*)(gbase) + (voff)[_i]), (PG8_LAS unsigned*)(lds + (bufoff) + ldsw + _i * 8192), 16, 0, 0); } while (0)
#define PG8_LDA(dst, b, h) do { _Pragma("unroll") for (int m = 0; m < 4; ++m) _Pragma("unroll") for (int k = 0; k < 2; ++k) dst[m][k] = *(const PG8_LAS bf16x8*)(lds + PG8_SA(b, h) + aoff + m * 2048 + k * 1024); } while (0)
#define PG8_LDB(dst, b, h) do { _Pragma("unroll") for (int n = 0; n < 2; ++n) _Pragma("unroll") for (int k = 0; k < 2; ++k) dst[n][k] = *(const PG8_LAS bf16x8*)(lds + PG8_SB(b, h) + boff + n * 2048 + k * 1024); } while (0)
#define PG8_MMA(ai, bj, At, Bt) do { __builtin_amdgcn_s_setprio(1); _Pragma("unroll") for (int m = 0; m < 4; ++m) _Pragma("unroll") for (int n = 0; n < 2; ++n) _Pragma("unroll") for (int k = 0; k < 2; ++k) \
        acc[ai][bj][m][n] = __builtin_amdgcn_mfma_f32_16x16x32_f16(__builtin_bit_cast(pg8_h8, Bt[n][k]), __builtin_bit_cast(pg8_h8, At[m][k]), acc[ai][bj][m][n], 0, 0, 0); __builtin_amdgcn_s_setprio(0); } while (0)
#define PG8_WAIT_V(n) asm volatile("s_waitcnt vmcnt(" #n ")" ::: "memory")
#define PG8_WAIT_L(n) asm volatile("s_waitcnt lgkmcnt(" #n ")" ::: "memory")
#define PG8_BAR __builtin_amdgcn_s_barrier()
#define PG8_SCHED __builtin_amdgcn_sched_barrier(0)
    Unit cur, nxt; int ui = 0;
    if (!S.next(0, cur)) return;
    f32x4 acc[2][2][4][2];
#pragma unroll
    for (int a = 0; a < 2; ++a)
#pragma unroll
        for (int b = 0; b < 2; ++b)
#pragma unroll
            for (int m = 0; m < 4; ++m)
#pragma unroll
                for (int n = 0; n < 2; ++n) acc[a][b][m][n] = (f32x4){0.f, 0.f, 0.f, 0.f};
    bf16x8 At[4][2], B0[2][2], B1[2][2];
    const char* cA = (const char*)g.A + (size_t)cur.pm * tstep; const char* cB = (const char*)g.Bt + (size_t)cur.pn * tstep;
    S.a_ready(cur);
    if constexpr (SP2) {
        PG8_STAGE(PG8_SB(0, 0), cB, voffB); PG8_STAGE(PG8_SB(0, 1), cB + hstep, voffB); PG8_STAGE(PG8_SA(0, 0), cA, voffA); PG8_STAGE(PG8_SA(0, 1), cA + hstep, voffA);
        if (wr == 1) PG8_BAR;
        PG8_WAIT_V(2); PG8_BAR;
        PG8_STAGE(PG8_SB(1, 0), cB + kstep, voffB); PG8_STAGE(PG8_SA(1, 0), cA + kstep, voffA); PG8_STAGE(PG8_SB(1, 1), cB + hstep + kstep, voffB);
        PG8_WAIT_V(6); PG8_BAR;
    } else {
        PG8_STAGE(PG8_SB(0, 0), cB, voffB); PG8_STAGE(PG8_SA(0, 0), cA, voffA); PG8_STAGE(PG8_SB(0, 1), cB + hstep, voffB); PG8_STAGE(PG8_SA(0, 1), cA + hstep, voffA);
        if (wr == 1) PG8_BAR;
        PG8_WAIT_V(4); PG8_BAR;
        PG8_STAGE(PG8_SB(1, 0), cB + kstep, voffB); PG8_STAGE(PG8_SA(1, 0), cA + kstep, voffA); PG8_STAGE(PG8_SB(1, 1), cB + hstep + kstep, voffB);
        PG8_WAIT_V(6); PG8_BAR;
    }
    for (;;) {
        const bool has_next = S.next(ui + 1, nxt);
        const char* nA = has_next ? (const char*)g.A + (size_t)nxt.pm * tstep : cA; const char* nB = has_next ? (const char*)g.Bt + (size_t)nxt.pn * tstep : cB;
        for (int t = 0; t < nt; t += 2) {
            const bool last = (t == nt - 2);
            const char* a1 = cA + (size_t)(t + 1) * kstep;
            const char* a2 = last ? nA : cA + (size_t)(t + 2) * kstep; const char* b2 = last ? nB : cB + (size_t)(t + 2) * kstep;
            const char* a3 = a2 + kstep; const char* b3 = b2 + kstep;
            if (last && has_next) S.a_ready(nxt);
            if constexpr (SP2) {
            PG8_LDB(B0, 0, 0); PG8_LDB(B1, 0, 1); PG8_SCHED; PG8_LDA(At, 0, 0); PG8_STAGE(PG8_SA(1, 1), a1 + hstep, voffA);
            PG8_WAIT_V(8); PG8_WAIT_L(0); PG8_BAR; PG8_MMA(0, 0, At, B0); PG8_MMA(0, 1, At, B1); PG8_BAR; PG8_SCHED;
            PG8_LDA(At, 0, 1); PG8_STAGE(PG8_SB(0, 0), b2, voffB); PG8_STAGE(PG8_SB(0, 1), b2 + hstep, voffB); PG8_STAGE(PG8_SA(0, 0), a2, voffA);
            PG8_WAIT_V(8); PG8_WAIT_L(0); PG8_BAR; PG8_MMA(1, 0, At, B0); PG8_MMA(1, 1, At, B1); PG8_BAR; PG8_SCHED;
            PG8_LDB(B0, 1, 0); PG8_LDB(B1, 1, 1); PG8_SCHED; PG8_LDA(At, 1, 0); PG8_STAGE(PG8_SA(0, 1), a2 + hstep, voffA);
            PG8_WAIT_V(8); PG8_WAIT_L(0); PG8_BAR; PG8_MMA(0, 0, At, B0); PG8_MMA(0, 1, At, B1); PG8_BAR; PG8_SCHED;
            PG8_LDA(At, 1, 1); PG8_STAGE(PG8_SB(1, 0), b3, voffB); PG8_STAGE(PG8_SB(1, 1), b3 + hstep, voffB); PG8_STAGE(PG8_SA(1, 0), a3, voffA);
            PG8_WAIT_V(8); PG8_WAIT_L(0); PG8_BAR; PG8_MMA(1, 0, At, B0); PG8_MMA(1, 1, At, B1); PG8_BAR; PG8_SCHED;
            } else {
            PG8_LDB(B0, 0, 0); PG8_SCHED; PG8_LDA(At, 0, 0); PG8_STAGE(PG8_SA(1, 1), a1 + hstep, voffA);
            PG8_WAIT_L(8); PG8_BAR; PG8_WAIT_L(0); PG8_MMA(0, 0, At, B0); PG8_BAR; PG8_SCHED;
            PG8_LDB(B1, 0, 1); PG8_STAGE(PG8_SB(0, 0), b2, voffB);
            PG8_BAR; PG8_WAIT_L(0); PG8_MMA(0, 1, At, B1); PG8_BAR;
            PG8_LDA(At, 0, 1); PG8_STAGE(PG8_SA(0, 0), a2, voffA);
            PG8_BAR; PG8_WAIT_L(0); PG8_MMA(1, 0, At, B0); PG8_BAR; PG8_SCHED;
            PG8_STAGE(PG8_SB(0, 1), b2 + hstep, voffB);
            PG8_WAIT_V(6); PG8_BAR; PG8_MMA(1, 1, At, B1); PG8_BAR;
            PG8_LDB(B0, 1, 0); PG8_SCHED; PG8_LDA(At, 1, 0); PG8_STAGE(PG8_SA(0, 1), a2 + hstep, voffA);
            PG8_WAIT_L(8); PG8_BAR; PG8_WAIT_L(0); PG8_MMA(0, 0, At, B0); PG8_BAR; PG8_SCHED;
            PG8_LDB(B1, 1, 1); PG8_STAGE(PG8_SB(1, 0), b3, voffB);
            PG8_BAR; PG8_WAIT_L(0); PG8_MMA(0, 1, At, B1); PG8_BAR;
            PG8_LDA(At, 1, 1); PG8_STAGE(PG8_SA(1, 0), a3, voffA);
            PG8_BAR; PG8_WAIT_L(0); PG8_MMA(1, 0, At, B0); PG8_BAR; PG8_SCHED;
            PG8_STAGE(PG8_SB(1, 1), b3 + hstep, voffB);
            PG8_WAIT_V(6); PG8_BAR; PG8_MMA(1, 1, At, B1); PG8_BAR;
            }
        }
        if constexpr (ALIGN_EPI) { if (wr == 0) PG8_BAR; }
        if constexpr (!Epi::AFTER_DRAIN) { E(acc, cur, wr, wc, fr, fq); S.done(cur); }
        if (!has_next) break;
#pragma unroll
        for (int a = 0; a < 2; ++a)
#pragma unroll
            for (int b = 0; b < 2; ++b)
#pragma unroll
                for (int m = 0; m < 4; ++m)
#pragma unroll
                    for (int n = 0; n < 2; ++n) acc[a][b][m][n] = (f32x4){0.f, 0.f, 0.f, 0.f};
        cur = nxt; cA = nA; cB = nB; ++ui;
        if constexpr (ALIGN_EPI) { if (wr == 1) PG8_BAR; }
    }
    PG8_WAIT_V(0);
    if constexpr (!ALIGN_EPI) { if (wr == 0) PG8_BAR; }
    PG8_BAR;
    if constexpr (Epi::AFTER_DRAIN) { E.fused(acc, cur, wr, wc, fr, fq, lds, wid, lane); S.done(cur); }
#undef PG8_SA
#undef PG8_SB
#undef PG8_STAGE
#undef PG8_LDA
#undef PG8_LDB
#undef PG8_MMA
#undef PG8_WAIT_V
#undef PG8_WAIT_L
#undef PG8_BAR
#undef PG8_SCHED
}
}
#define LAS __attribute__((address_space(3)))
typedef unsigned short bf16;
typedef unsigned v4u __attribute__((ext_vector_type(4)));
typedef unsigned v2u __attribute__((ext_vector_type(2)));
typedef float f32x4 __attribute__((ext_vector_type(4)));
typedef float f32x2 __attribute__((ext_vector_type(2)));
typedef float f32x16 __attribute__((ext_vector_type(16)));
typedef short bf16x8 __attribute__((ext_vector_type(8)));

constexpr int NB = 8, S = 4096, M = NB * S, D = 1024, FF = 2816, NH = 8, HD = 64, RW = 512;
constexpr int PRW_LD = 1824, NPH_LAYER = 14, NPHASES = 1 + 4 * NPH_LAYER;
constexpr float LOG2E = 1.4426950408889634f, LN2 = 0.6931471805599453f;
constexpr size_t MiB = 1u << 20, HM = MiB / 2;
constexpr size_t WS_CTL = 0, WS_MOD = 1 * MiB;
constexpr size_t WS_WG1 = 3 * MiB, WS_WG2 = 14 * MiB, WS_WIN = 19 * MiB + HM, WS_WUPA = 30 * MiB + HM, WS_WUPB = 31 * MiB + HM, WS_WOUT = 32 * MiB + HM,
                 WS_WG1B = 34 * MiB + HM, WS_WG2B = 45 * MiB + HM, WS_WLORA = 51 * MiB;
constexpr size_t WS_PRW = 53 * MiB, WS_Q = 167 * MiB, WS_K = 199 * MiB, WS_VT = 231 * MiB, WS_H16 = 263 * MiB, WS_ACT = 53 * MiB;
constexpr size_t WS_WL2 = 53 * MiB, WS_BB = 85 * MiB, WS_GG = 117 * MiB, WS_MERGED = 53 * MiB;
constexpr size_t WS_R = 391 * MiB, WS_KM = 423 * MiB, WS_KK = 455 * MiB, WS_VV = 487 * MiB, WS_N = 391 * MiB, WS_TEMP = 391 * MiB;
constexpr size_t WS_YA = 519 * MiB, WS_YB = 551 * MiB, WS_ALORA = 519 * MiB, WS_VFIRST = 583 * MiB, WS_BONUS = 615 * MiB, WS_END = 616 * MiB;
constexpr int LDS_BYTES = 147456, MISC_OFF = 131072;

typedef _Float16 h16x2 __attribute__((ext_vector_type(2)));
typedef _Float16 h16x8 __attribute__((ext_vector_type(8)));
__device__ __forceinline__ unsigned f2bf(float f) { return (unsigned)__builtin_bit_cast(unsigned short, (_Float16)f); }
__device__ __forceinline__ unsigned pk2(float lo, float hi) { const h16x2 v = {(_Float16)lo, (_Float16)hi}; return __builtin_bit_cast(unsigned, v); }
__device__ __forceinline__ float bflo(unsigned u) { const h16x2 v = __builtin_bit_cast(h16x2, u); return (float)v.x; }
__device__ __forceinline__ float bfhi(unsigned u) { const h16x2 v = __builtin_bit_cast(h16x2, u); return (float)v.y; }
__device__ __forceinline__ float fexp(float x) { return __builtin_amdgcn_exp2f(x * LOG2E); }
__device__ __forceinline__ float flog(float x) { return __builtin_amdgcn_logf(x) * LN2; }
__device__ __forceinline__ float sigmoidf_(float x) { return __builtin_amdgcn_rcpf(1.f + fexp(-x)); }
#define SHX(v, o) __uint_as_float(__builtin_amdgcn_ds_bpermute(((lane) ^ (o)) << 2, __float_as_uint(v)))
__device__ __forceinline__ float wave_sum(float v, int lane) {
#pragma unroll
    for (int o = 1; o < 64; o <<= 1) v += SHX(v, o);
    return v;
}
template <int CTRL> __device__ __forceinline__ float dppf(float x) { return __uint_as_float(__builtin_amdgcn_update_dpp(0u, __float_as_uint(x), CTRL, 0xf, 0xf, false)); }
__device__ __forceinline__ float red16(float x) { x += dppf<0x128>(x); x += dppf<0x124>(x); x += dppf<0x122>(x); x += dppf<0x121>(x); return x; }
#define LDS_WAIT() asm volatile("s_waitcnt lgkmcnt(0)" ::: "memory")

struct Args { const float* in[31]; float* out; unsigned char* ws; int ph_lo, ph_hi; };
typedef const __attribute__((address_space(4))) Args* CArgs;
#define EPI_FENCE() asm volatile("" ::: "memory")

__device__ __forceinline__ int fresh_lane() { int ln; asm volatile("v_mbcnt_lo_u32_b32 %0, -1, 0\n\tv_mbcnt_hi_u32_b32 %0, -1, %0" : "=v"(ln)); return ln; }
#define EPI_IDX() const int t_ = fresh_lane(); const int fr = t_ & 15, fq = t_ >> 4
__device__ __forceinline__ v4u pack8(const f32x4 a, const f32x4 b);
struct EpiSwiglu {
    static constexpr bool PERM = true, AFTER_DRAIN = false;
    bf16* act;
    __device__ __forceinline__ void operator()(const f32x4 (&acc)[2][2][4][2], const pg8::Unit& u, int wr, int wc, int, int) const {
        EPI_IDX();
        const int row0 = u.pm * 256 + wr * 64 + fr, f0 = u.pn * 128 + wc * 32 + fq * 8;
#pragma unroll
        for (int ai = 0; ai < 2; ++ai)
#pragma unroll
            for (int m = 0; m < 4; ++m) { bf16* rp = act + (size_t)(row0 + ai * 128 + m * 16) * FF + f0; f32x4 o[2];
#pragma unroll
                for (int n = 0; n < 2; ++n) { const f32x4 g = acc[ai][0][m][n], uu = acc[ai][1][m][n];
#pragma unroll
                    for (int j = 0; j < 4; ++j) o[n][j] = g[j] * uu[j] * __builtin_amdgcn_rcpf(1.f + __builtin_amdgcn_exp2f(-g[j] * LOG2E)); }
                *(v4u*)rp = pack8(o[0], o[1]);
                EPI_FENCE(); }
    }
};
struct EpiResid {
    static constexpr bool PERM = true, AFTER_DRAIN = false;
    CArgs a; int l, idx;
    __device__ __forceinline__ void operator()(const f32x4 (&acc)[2][2][4][2], const pg8::Unit& u, int wr, int wc, int, int) const {
        EPI_IDX();
        unsigned char* ws = a->ws; const float* mod = (const float*)(ws + WS_MOD);
        const bool in32 = (l == 0 && idx == 2), out32 = (l == 3 && idx == 13);
        const float* x32 = a->in[0]; float* o32 = a->out; bf16* h16 = (bf16*)(ws + WS_H16);
        const float* gt = mod + (size_t)l * 8 * 9216 + (idx == 2 ? 2 : (idx == 10 ? 5 : 8)) * 1024; const float fac = idx == 10 ? 1.f : 0.5f;
        const int row0 = u.pm * 256 + wr * 64 + fr, col0 = u.pn * 256 + wc * 32 + 8 * fq, b = u.pm >> 4;
#pragma unroll
        for (int bj = 0; bj < 2; ++bj) { const int col = col0 + bj * 128; const f32x4 g0 = *(const f32x4*)(gt + b * 9216 + col) * fac, g1 = *(const f32x4*)(gt + b * 9216 + col + 4) * fac;
#pragma unroll
            for (int ai = 0; ai < 2; ++ai)
#pragma unroll
                for (int m = 0; m < 4; ++m) { const size_t off = (size_t)(row0 + ai * 128 + m * 16) * D + col; f32x4 h0, h1;
                    if (in32) { h0 = *(const f32x4*)(x32 + off); h1 = *(const f32x4*)(x32 + off + 4); }
                    else { const v4u q = *(const v4u*)(h16 + off); h0 = (f32x4){bflo(q.x), bfhi(q.x), bflo(q.y), bfhi(q.y)}; h1 = (f32x4){bflo(q.z), bfhi(q.z), bflo(q.w), bfhi(q.w)}; }
                    const f32x4 o0 = h0 + g0 * acc[ai][bj][m][0], o1 = h1 + g1 * acc[ai][bj][m][1];
                    if (out32) { *(f32x4*)(o32 + off) = o0; *(f32x4*)(o32 + off + 4) = o1; }
                    else { v4u w; w.x = pk2(o0[0], o0[1]); w.y = pk2(o0[2], o0[3]); w.z = pk2(o1[0], o1[1]); w.w = pk2(o1[2], o1[3]); *(v4u*)(h16 + off) = w; }
                    if (m & 1) EPI_FENCE(); } }
    }
};
__device__ __forceinline__ v4u pack8(const f32x4 a, const f32x4 b) { v4u w; w.x = pk2(a[0], a[1]); w.y = pk2(a[2], a[3]); w.z = pk2(b[0], b[1]); w.w = pk2(b[2], b[3]); return w; }
struct EpiIn {
    static constexpr bool PERM = true, AFTER_DRAIN = false;
    unsigned char* ws; float* gates_base;
    __device__ __forceinline__ void operator()(const f32x4 (&acc)[2][2][4][2], const pg8::Unit& u, int wr, int wc, int, int) const {
        EPI_IDX();
        const int row0 = u.pm * 256 + wr * 64 + fr, pn = u.pn;
        bf16 *prw = (bf16*)(ws + WS_PRW), *q = (bf16*)(ws + WS_Q), *k = (bf16*)(ws + WS_K), *vt = (bf16*)(ws + WS_VT), *gates = (bf16*)gates_base;
#pragma unroll
        for (int ai = 0; ai < 2; ++ai)
#pragma unroll
            for (int m = 0; m < 4; ++m) { const int row = row0 + ai * 128 + m * 16;
#pragma unroll
                for (int bj = 0; bj < 2; ++bj) { const int col = pn * 256 + bj * 128 + wc * 32 + 8 * fq; const f32x4 v0 = acc[ai][bj][m][0], v1 = acc[ai][bj][m][1];
                    if (pn < 7) { *(v4u*)(prw + (size_t)row * PRW_LD + col) = pack8(v0, v1); }
                    else if (pn < 13) { const int c2 = col - 1792, which = c2 >> 9, hd = c2 & 511, hh = hd >> 6, d = hd & 63, b = row >> 12, s = row & 4095;
                        if (which < 2) { bf16* dst = (which ? k : q) + ((size_t)((b * NH + hh) * S + s)) * HD + d; *(v4u*)dst = pack8(v0, v1); }
                        else { bf16* dst = vt + ((size_t)((b * NH + hh) * HD + d)) * S + s;
#pragma unroll
                            for (int e = 0; e < 4; ++e) { dst[(size_t)e * S] = (bf16)f2bf(v0[e]); dst[(size_t)(e + 4) * S] = (bf16)f2bf(v1[e]); } } }
                    else if (pn < 21) { *(v4u*)(gates + (size_t)row * 2048 + (col - 3328)) = pack8(v0, v1); }
                    else { if (col < 5408) *(v4u*)(prw + (size_t)row * PRW_LD + 1792 + (col - 5376)) = pack8(v0, v1); } }
                EPI_FENCE(); }
    }
};
__device__ __forceinline__ f32x4 unpack4(const v2u q) { return (f32x4){bflo(q.x), bfhi(q.x), bflo(q.y), bfhi(q.y)}; }
__device__ __forceinline__ v2u pack4(const f32x4 a) { v2u w; w.x = pk2(a[0], a[1]); w.y = pk2(a[2], a[3]); return w; }
template <int GRPT> struct EpiLora {
    static constexpr bool PERM = true, AFTER_DRAIN = false;
    CArgs a; int l;
    template <int GRP> __device__ __forceinline__ void run(const f32x4 (&acc)[2][2][4][2], const pg8::Unit& u, int wr, int wc, int, int) const {
        EPI_IDX();
        const int row0 = u.pm * 256 + wr * 64 + fr;
        unsigned char* ws = a->ws;
        bf16 *km = (bf16*)(ws + WS_KM), *kk = (bf16*)(ws + WS_KK), *vv = (bf16*)(ws + WS_VV), *wl2 = (bf16*)(ws + WS_WL2), *bb = (bf16*)(ws + WS_BB), *gg = (bf16*)(ws + WS_GG); const bf16* vfirst = (const bf16*)(ws + WS_VFIRST);
        const float* pv = GRP == 0 ? a->in[11] + l * 512 : (GRP == 1 ? a->in[13] + l * 512 : a->in[21] + (l > 0 ? (l - 1) * 512 : 0));
        const float* ka = a->in[17] + l * 512;
#pragma unroll
        for (int bj = 0; bj < 2; ++bj)
#pragma unroll
            for (int n = 0; n < 2; ++n) { const int ch = (u.pn & 1) * 256 + bj * 128 + wc * 32 + 8 * fq + 4 * n;
                f32x4 c0 = (f32x4){0.f, 0.f, 0.f, 0.f}, ka0 = c0;
                if (GRP != 2) c0 = *(const f32x4*)(pv + ch);
                if (GRP == 1) ka0 = *(const f32x4*)(ka + ch);
#pragma unroll
                for (int ai = 0; ai < 2; ++ai)
#pragma unroll
                    for (int m = 0; m < 4; ++m) { const size_t off = (size_t)(row0 + ai * 128 + m * 16) * RW + ch; f32x4 x0 = acc[ai][bj][m][n] + c0;
                        if (GRP == 0) {
#pragma unroll
                            for (int e = 0; e < 4; ++e) { const float p = -x0[e]; const float sp = fmaxf(p, 0.f) + flog(1.f + fexp(-fabsf(p))); x0[e] = -fexp(-sp - 0.5f) * LOG2E; }
                            *(v2u*)(wl2 + off) = pack4(x0);
                        } else if (GRP == 1) {
#pragma unroll
                            for (int e = 0; e < 4; ++e) x0[e] = sigmoidf_(x0[e]);
                            *(v2u*)(bb + off) = pack4(x0);
                        } else if (GRP == 2) { *(v2u*)(gg + off) = pack4(x0);
                        } else { f32x4 a0_ = unpack4(*(const v2u*)(vv + off)); const f32x4 f0 = unpack4(*(const v2u*)(vfirst + off));
#pragma unroll
                            for (int e = 0; e < 4; ++e) a0_[e] += (f0[e] - a0_[e]) * sigmoidf_(x0[e]);
                            *(v2u*)(vv + off) = pack4(a0_); }
                        EPI_FENCE(); } }
    }
    __device__ __forceinline__ void operator()(const f32x4 (&acc)[2][2][4][2], const pg8::Unit& u, int wr, int wc, int, int) const { run<GRPT>(acc, u, wr, wc, 0, 0); }
};
struct EpiNull {
    static constexpr bool PERM = false, AFTER_DRAIN = false;
    float* sink;
    __device__ __forceinline__ void operator()(const f32x4 (&acc)[2][2][4][2], const pg8::Unit& u, int wr, int wc, int, int) const {
        float s = 0.f;
#pragma unroll
        for (int ai = 0; ai < 2; ++ai)
#pragma unroll
            for (int bj = 0; bj < 2; ++bj)
#pragma unroll
                for (int m = 0; m < 4; ++m)
#pragma unroll
                    for (int n = 0; n < 2; ++n) s += acc[ai][bj][m][n][0] + acc[ai][bj][m][n][1] + acc[ai][bj][m][n][2] + acc[ai][bj][m][n][3];
        if (s == 12345.678f) sink[0] = s;
    }
};
struct OffOrder {
    pg8::StaticOrder b; int off;
    __device__ bool next(int i, pg8::Unit& u) const { if (!b.next(i, u)) return false; u.pn += off; return true; }
    __device__ __forceinline__ void a_ready(const pg8::Unit&) const {}
    __device__ __forceinline__ void done(const pg8::Unit&) const {}
};
__device__ __forceinline__ void unpack8(const v4u q, float* x);
__device__ __forceinline__ v4u packarr(const float* x);
template <int SECOND> struct EpiUp {
    static constexpr bool PERM = true, AFTER_DRAIN = false;
    unsigned char* ws; const float* gates_base;
    __device__ __forceinline__ void operator()(const f32x4 (&acc)[2][2][4][2], const pg8::Unit& u, int wr, int wc, int, int) const {
        EPI_IDX();
        const int row0 = u.pm * 256 + wr * 64 + fr;
        const bf16* gates = (const bf16*)gates_base; bf16* merged = (bf16*)(ws + WS_MERGED);
#pragma unroll
        for (int ai = 0; ai < 2; ++ai)
#pragma unroll
            for (int m = 0; m < 4; ++m) { const int row = row0 + ai * 128 + m * 16;
#pragma unroll
                for (int bj = 0; bj < 2; ++bj) { const int col = u.pn * 256 + bj * 128 + wc * 32 + 8 * fq;
                    float g[8]; unpack8(*(const v4u*)(gates + (size_t)row * 2048 + SECOND * 1024 + col), g);
                    bf16* mp = merged + (size_t)row * D + col;
                    float o[8];
#pragma unroll
                    for (int e = 0; e < 4; ++e) { o[e] = sigmoidf_(g[e]) * acc[ai][bj][m][0][e]; o[e + 4] = sigmoidf_(g[e + 4]) * acc[ai][bj][m][1][e]; }
                    if (SECOND == 1) { float p[8]; unpack8(*(const v4u*)mp, p);
#pragma unroll
                        for (int e = 0; e < 8; ++e) o[e] += p[e]; }
                    *(v4u*)mp = packarr(o); }
                EPI_FENCE(); }
    }
};

__device__ __forceinline__ void phase_mod(CArgs a, LAS unsigned char* lds, int tid, int bid, int G) {
    LAS float* sc = (LAS float*)lds;
    LAS float* red = (LAS float*)(lds + 32768);
    float* mod = (float*)(a->ws + WS_MOD);
    const float* c = a->in[1];
    bool loaded = false;
    for (int it = bid; it < 144; it += G) {
        if (!loaded) { for (int i = tid; i < 8192; i += 512) { const int b = i >> 10, k = i & 1023; const float v = c[i]; sc[k * 8 + b] = v * sigmoidf_(v); } loaded = true; }
        __syncthreads();
        const int l = it / 36, j0 = (it % 36) * 256, ln = tid & 63, kq = tid >> 6;
        const float* w = a->in[2] + (size_t)l * 1024 * 9216 + j0 + 4 * ln;
        f32x4 a0[4], a1[4];
#pragma unroll
        for (int q = 0; q < 4; ++q) { a0[q] = (f32x4){0.f, 0.f, 0.f, 0.f}; a1[q] = a0[q]; }
#pragma unroll 8
        for (int k = kq * 128; k < kq * 128 + 128; ++k) { const f32x4 wv = *(const f32x4*)(w + (size_t)k * 9216); const f32x4 s0 = *(LAS const f32x4*)(sc + k * 8), s1 = *(LAS const f32x4*)(sc + k * 8 + 4);
#pragma unroll
            for (int q = 0; q < 4; ++q) { a0[q] += wv[q] * s0; a1[q] += wv[q] * s1; } }
#pragma unroll
        for (int q = 0; q < 4; ++q) { *(LAS f32x4*)(red + ((kq * 256 + 4 * ln + q) * 8)) = a0[q]; *(LAS f32x4*)(red + ((kq * 256 + 4 * ln + q) * 8) + 4) = a1[q]; }
        __syncthreads();
        for (int o = tid; o < 2048; o += 512) { const int cc = o >> 3, bq = o & 7; float sum = 0.f;
#pragma unroll
            for (int q = 0; q < 8; ++q) sum += red[(q * 256 + cc) * 8 + bq];
            mod[(size_t)(l * 8 + bq) * 9216 + j0 + cc] = sum + a->in[3][l * 9216 + j0 + cc]; }
        __syncthreads();
    }
}
template <int MAP> __device__ __forceinline__ void tr_item(const float* W, int K, int N, bf16* WT, LAS float* scr, int item, int lane) {
    const int nblk = N / 32, kb = item / nblk, nb = item % nblk, k0 = 64 * kb, n0 = 32 * nb;
    {
        const int nq = (lane & 7) * 4;
#pragma unroll
        for (int i = 0; i < 8; ++i) { const int kk = 8 * i + (lane >> 3); const f32x4 w4 = *(const f32x4*)(W + (size_t)(k0 + kk) * N + n0 + nq);
            LAS float* d = scr + kk * 33 + nq; d[0] = w4.x; d[1] = w4.y; d[2] = w4.z; d[3] = w4.w; } }
    LDS_WAIT();
    const int c = lane & 7;
#pragma unroll
    for (int j = 0; j < 4; ++j) { const int n = (lane >> 3) + 8 * j; const LAS float* s = scr + (8 * c) * 33 + n;
        v4u o; o.x = pk2(s[0 * 33], s[1 * 33]); o.y = pk2(s[2 * 33], s[3 * 33]); o.z = pk2(s[4 * 33], s[5 * 33]); o.w = pk2(s[6 * 33], s[7 * 33]);
        const int nn = n0 + n; const int dr = MAP == 0 ? nn : ((nn >> 7) * 256 + (MAP == 2 ? 128 : 0) + (nn & 127));
        *(v4u*)(WT + (size_t)dr * K + k0 + 8 * c) = o; }
    LDS_WAIT();
}
__device__ __forceinline__ void phase_convert(CArgs a, LAS unsigned char* lds, int l, int gw, int NGW, int wave, int lane, int gtid, int GT) {
    LAS float* scr = (LAS float*)(lds + wave * 16384);
    unsigned char* ws = a->ws;
    const size_t fo = (size_t)l * 1024 * FF;
    const int nin = l == 0 ? 5376 : 5408;
    const float* win = l == 0 ? a->in[8] : a->in[9] + (size_t)(l - 1) * 1024 * 5408;
    const int I_F = 1408, I_IN = 16 * (nin / 32), I_UP = 256, I_OUT = 512;
    const int total = 6 * I_F + I_IN + 2 * I_UP + I_OUT;
    for (int it = gw; it < total; it += NGW) {
        int r = it;
        if (r < I_F) { tr_item<1>(a->in[5] + fo, 1024, FF, (bf16*)(ws + WS_WG1), scr, r, lane); continue; } r -= I_F;
        if (r < I_F) { tr_item<2>(a->in[6] + fo, 1024, FF, (bf16*)(ws + WS_WG1), scr, r, lane); continue; } r -= I_F;
        if (r < I_F) { tr_item<0>(a->in[7] + fo, FF, 1024, (bf16*)(ws + WS_WG2), scr, r, lane); continue; } r -= I_F;
        if (r < I_F) { tr_item<1>(a->in[28] + fo, 1024, FF, (bf16*)(ws + WS_WG1B), scr, r, lane); continue; } r -= I_F;
        if (r < I_F) { tr_item<2>(a->in[29] + fo, 1024, FF, (bf16*)(ws + WS_WG1B), scr, r, lane); continue; } r -= I_F;
        if (r < I_F) { tr_item<0>(a->in[30] + fo, FF, 1024, (bf16*)(ws + WS_WG2B), scr, r, lane); continue; } r -= I_F;
        if (r < I_IN) { tr_item<0>(win, 1024, nin, (bf16*)(ws + WS_WIN), scr, r, lane); continue; } r -= I_IN;
        if (r < I_UP) { tr_item<0>(a->in[25] + (size_t)l * 512 * 1024, 512, 1024, (bf16*)(ws + WS_WUPA), scr, r, lane); continue; } r -= I_UP;
        if (r < I_UP) { tr_item<0>(a->in[26] + (size_t)l * 512 * 1024, 512, 1024, (bf16*)(ws + WS_WUPB), scr, r, lane); continue; } r -= I_UP;
        tr_item<0>(a->in[27] + (size_t)l * 1024 * 1024, 1024, 1024, (bf16*)(ws + WS_WOUT), scr, r, lane);
    }
    bf16* wl = (bf16*)(ws + WS_WLORA);
    for (int ci = gtid; ci < 2048 * 48; ci += GT) { const int n = ci / 48, kc = ci % 48, grp = n >> 9, ch = n & 511; float v[8];
#pragma unroll
        for (int e = 0; e < 8; ++e) { const int kk = kc * 8 + e; float x = 0.f;
            if (grp == 0) { if (kk < 64) x = a->in[12][((size_t)l * 64 + kk) * 512 + ch]; }
            else if (grp == 1) { if (kk >= 64 && kk < 128) x = a->in[14][((size_t)l * 64 + (kk - 64)) * 512 + ch]; }
            else if (grp == 2) { if (kk >= 128 && kk < 256) x = a->in[15][((size_t)l * 128 + (kk - 128)) * 512 + ch]; }
            else { if (l > 0 && kk >= 256 && kk < 288) x = a->in[22][((size_t)(l - 1) * 32 + (kk - 256)) * 512 + ch]; }
            v[e] = x; }
        v4u o; o.x = pk2(v[0], v[1]); o.y = pk2(v[2], v[3]); o.z = pk2(v[4], v[5]); o.w = pk2(v[6], v[7]);
        *(v4u*)(wl + (size_t)n * 384 + kc * 8) = o; }
}
__device__ __forceinline__ void phase_norm(const float* x32, const bf16* h16, const float* g, const float* modl, int i3, bf16* nout, int gw, int NGW, int lane) {
#pragma unroll 2
    for (int m = gw; m < M; m += NGW) { const int b = m >> 12; const float* sh = modl + (size_t)b * 9216 + (3 * i3) * 1024; const float* sc = sh + 1024;
        float v[2][8]; float ss = 0.f;
#pragma unroll
        for (int j = 0; j < 2; ++j) { const int col = 8 * lane + 512 * j;
            if (x32) { const f32x4 a0 = *(const f32x4*)(x32 + (size_t)m * D + col), a1 = *(const f32x4*)(x32 + (size_t)m * D + col + 4);
#pragma unroll
                for (int e = 0; e < 4; ++e) { v[j][e] = a0[e]; v[j][e + 4] = a1[e]; } }
            else unpack8(*(const v4u*)(h16 + (size_t)m * D + col), v[j]);
#pragma unroll
            for (int e = 0; e < 8; ++e) ss += v[j][e] * v[j][e]; }
        const float rstd = __builtin_amdgcn_rsqf(wave_sum(ss, lane) * (1.f / D) + 1e-6f);
#pragma unroll
        for (int j = 0; j < 2; ++j) { const int col = 8 * lane + 512 * j; float y[8];
            const f32x4 g0 = *(const f32x4*)(g + col), g1 = *(const f32x4*)(g + col + 4), s0 = *(const f32x4*)(sc + col), s1 = *(const f32x4*)(sc + col + 4), h0 = *(const f32x4*)(sh + col), h1 = *(const f32x4*)(sh + col + 4);
#pragma unroll
            for (int e = 0; e < 4; ++e) { y[e] = v[j][e] * rstd * g0[e] * (1.f + s0[e]) + h0[e]; y[e + 4] = v[j][e + 4] * rstd * g1[e] * (1.f + s1[e]) + h1[e]; }
            *(v4u*)(nout + (size_t)m * D + col) = packarr(y); } }
}
__device__ __forceinline__ void unpack8(const v4u q, float* x) { x[0] = bflo(q.x); x[1] = bfhi(q.x); x[2] = bflo(q.y); x[3] = bfhi(q.y); x[4] = bflo(q.z); x[5] = bfhi(q.z); x[6] = bflo(q.w); x[7] = bfhi(q.w); }
__device__ __forceinline__ v4u packarr(const float* x) { v4u o; o.x = pk2(x[0], x[1]); o.y = pk2(x[2], x[3]); o.z = pk2(x[4], x[5]); o.w = pk2(x[6], x[7]); return o; }
__device__ __forceinline__ void phase_prep(CArgs a, int l, int gw, int NGW, int lane, const bool do_qk = true) {
    unsigned char* ws = a->ws;
    const bf16* prw = (const bf16*)(ws + WS_PRW);
    bf16 *R = (bf16*)(ws + WS_R), *KM = (bf16*)(ws + WS_KM), *KK = (bf16*)(ws + WS_KK), *VV = (bf16*)(ws + WS_VV), *VF = (bf16*)(ws + WS_VFIRST), *AL = (bf16*)(ws + WS_ALORA);
    const float* mu = a->in[10] + (size_t)l * 1792; const float* kkw = a->in[16] + (size_t)l * 512;
    const v4u z4 = (v4u){0u, 0u, 0u, 0u};
#pragma unroll 2
    for (int m = gw; m < M; m += NGW) { const int s = m & 4095, b = m >> 12; const bool hp = s != 0;
        const bf16* cur = prw + (size_t)m * PRW_LD; const bf16* prv = cur - PRW_LD;
#pragma unroll
        for (int i = 0; i < 3; ++i) { const int col = (lane + 64 * i) * 8; float c[8], p[8], x[8];
            unpack8(*(const v4u*)(cur + col), c); unpack8(hp ? *(const v4u*)(prv + col) : z4, p);
            const f32x4 m0 = *(const f32x4*)(mu + col), m1 = *(const f32x4*)(mu + col + 4);
#pragma unroll
            for (int e = 0; e < 4; ++e) { x[e] = c[e] + (p[e] - c[e]) * m0[e]; x[e + 4] = c[e + 4] + (p[e + 4] - c[e + 4]) * m1[e]; }
            const size_t off = (size_t)m * RW + lane * 8;
            if (i == 0) *(v4u*)(R + off) = packarr(x);
            else if (i == 1) { *(v4u*)(KM + off) = packarr(x); const f32x4 k0 = *(const f32x4*)(kkw + lane * 8), k1 = *(const f32x4*)(kkw + lane * 8 + 4); float ss = 0.f;
#pragma unroll
                for (int e = 0; e < 4; ++e) { x[e] *= k0[e]; x[e + 4] *= k1[e]; ss += x[e] * x[e] + x[e + 4] * x[e + 4]; }
                ss += SHX(ss, 1); ss += SHX(ss, 2); ss += SHX(ss, 4);
                const float inv = fminf(__builtin_amdgcn_rsqf(ss), 1e12f);
#pragma unroll
                for (int e = 0; e < 8; ++e) x[e] *= inv;
                *(v4u*)(KK + off) = packarr(x); }
            else { const v4u o = packarr(x); *(v4u*)(VV + off) = o; if (l == 0) *(v4u*)(VF + off) = o; } }
        if (lane < 48) { float x[8];
            if (lane < 32) { const int col = 1536 + lane * 8; float c[8], p[8];
                unpack8(*(const v4u*)(cur + col), c); unpack8(hp ? *(const v4u*)(prv + col) : z4, p);
#pragma unroll
                for (int e = 0; e < 8; ++e) { const float xx = c[e] + (p[e] - c[e]) * mu[col + e];
                    x[e] = lane < 8 ? (1.f - 2.f * __builtin_amdgcn_rcpf(fexp(2.f * xx) + 1.f)) : (lane < 16 ? xx : sigmoidf_(xx)); } }
            else if (lane < 36 && l > 0) { unpack8(*(const v4u*)(cur + 1792 + (lane - 32) * 8), x); }
            else {
#pragma unroll
                for (int e = 0; e < 8; ++e) x[e] = 0.f; }
            *(v4u*)(AL + (size_t)m * 384 + lane * 8) = packarr(x); }
    }
}
constexpr int SC_T = 32, SC_NP = 16, SC_VEC = 0, SC_SCAL = 9216, SC_V = 9280, SC_BUFF = 9792, SC_BUF = SC_BUFF * 4, SC_YB = 2 * SC_BUF;
__device__ __forceinline__ f32x4 h4(const v2u q) { return (f32x4){bflo(q.x), bfhi(q.x), bflo(q.y), bfhi(q.y)}; }
__device__ __forceinline__ float dot4(const f32x4 a, const f32x4 b) { f32x2 t = (f32x2){a.x, a.y} * (f32x2){b.x, b.y}; t = (f32x2){a.z, a.w} * (f32x2){b.z, b.w} + t; return t.x + t.y; }
__device__ __forceinline__ void scan_unit(CArgs a, LAS unsigned char* lds, int l, int hh, int qq, int tid) {
    unsigned char* ws = a->ws;
    const int b = hh >> 3, h = hh & 7;
    constexpr int NC = S / SC_T;
    if (tid >= 256) {
        const int ht = tid - 256, hp = ht >> 4, hl = ht & 15;
        const size_t goff = ((size_t)b * S + 2 * hp) * RW + h * 64 + hl * 4;
        const bf16 *t0 = (const bf16*)(ws + WS_R) + goff, *t1 = (const bf16*)(ws + WS_WL2) + goff, *t2 = (const bf16*)(ws + WS_KM) + goff, *t3 = (const bf16*)(ws + WS_KK) + goff, *t4 = (const bf16*)(ws + WS_BB) + goff;
        const bf16* t5 = (const bf16*)(ws + WS_VV) + ((size_t)b * S + (ht >> 1)) * RW + h * 64 + 16 * qq + (ht & 1) * 8;
        const int ytok = ht >> 3, ypart = ht & 7;
        const f32x4 kah = *(const f32x4*)(a->in[17] + l * 512 + h * 64 + hl * 4);
        const f32x4 rkh = *(const f32x4*)(a->in[18] + l * 512 + h * 64 + hl * 4);
        float* bon = (float*)(ws + WS_BONUS) + (size_t)b * S * 8 + h;
        bf16* yo = (bf16*)(ws + WS_YA) + ((size_t)b * S + ytok) * RW + h * 64 + 16 * qq + 2 * ypart;
        v2u r0q, r1q, w0q, w1q, k0q, k1q, n0q, n1q, b0q, b1q; v4u vq = (v4u){0u, 0u, 0u, 0u};
#define SC_HLOAD(cc) { const size_t o2 = (size_t)(cc) * SC_T * RW; r0q = *(const v2u*)(t0 + o2); r1q = *(const v2u*)(t0 + o2 + RW); w0q = *(const v2u*)(t1 + o2); w1q = *(const v2u*)(t1 + o2 + RW); \
            k0q = *(const v2u*)(t2 + o2); k1q = *(const v2u*)(t2 + o2 + RW); n0q = *(const v2u*)(t3 + o2); n1q = *(const v2u*)(t3 + o2 + RW); b0q = *(const v2u*)(t4 + o2); b1q = *(const v2u*)(t4 + o2 + RW); \
            if (ht < 64) vq = *(const v4u*)(t5 + o2); }
#define SC_HSTORE(cc) { LAS float* B = (LAS float*)(lds + ((cc) & 1) * SC_BUF); LAS float* vb = B + (hp * 9) * 64 + hl * 4; \
            const f32x4 r0 = h4(r0q), r1 = h4(r1q), n0 = h4(n0q), n1 = h4(n1q), as0 = h4(b0q), as1 = h4(b1q); f32x4 w0 = h4(w0q), w1 = h4(w1q); \
            const f32x4 k0 = h4(k0q) * ((as0 - 1.f) * kah + 1.f), k1 = h4(k1q) * ((as1 - 1.f) * kah + 1.f), b0 = n0 * as0, b1 = n1 * as1;     \
            _Pragma("unroll") for (int e = 0; e < 4; ++e) { w0[e] = __builtin_amdgcn_exp2f(w0[e]); w1[e] = __builtin_amdgcn_exp2f(w1[e]); } \
            *(LAS f32x4*)(vb) = n0; *(LAS f32x4*)(vb + 64) = w0 * n1; *(LAS f32x4*)(vb + 128) = w0 * w1; *(LAS f32x4*)(vb + 192) = b0 * w1; *(LAS f32x4*)(vb + 256) = k0 * w1; \
            *(LAS f32x4*)(vb + 320) = b1; *(LAS f32x4*)(vb + 384) = k1; *(LAS f32x4*)(vb + 448) = w0 * r0; *(LAS f32x4*)(vb + 512) = r1; \
            const float c1 = -red16(dot4(b0, n1)), c2 = -red16(dot4(k0, n1)), c3 = red16(dot4(b0, r0)), c4 = red16(dot4(k0, r0)); \
            if (hl == 0) *(LAS f32x4*)(B + SC_SCAL + hp * 4) = (f32x4){c1, c2, c3, c4}; \
            if (qq == 0) { const float bs0 = red16(dot4(r0 * k0, rkh)), bs1 = red16(dot4(r1 * k1, rkh)); if (hl == 0) { bon[((size_t)(cc) * SC_T + 2 * hp) * 8] = bs0; bon[((size_t)(cc) * SC_T + 2 * hp + 1) * 8] = bs1; } } \
            if (ht < 64) { float x[8]; unpack8(vq, x); const int vt = ht >> 1; LAS float* d = B + SC_V + ((vt >> 1) * 16 + (ht & 1) * 8) * 2 + (vt & 1); \
                _Pragma("unroll") for (int e = 0; e < 8; ++e) d[2 * e] = x[e]; } }
#define SC_HBAR() { asm volatile("s_waitcnt lgkmcnt(0)" ::: "memory"); __builtin_amdgcn_s_barrier(); asm volatile("" ::: "memory"); }
        SC_HLOAD(0); SC_HSTORE(0); SC_HLOAD(1);
        SC_HBAR();
        for (int c = 0; c < NC; ++c) {
            if (c + 1 < NC) SC_HSTORE(c + 1);
            if (c + 2 < NC) SC_HLOAD(c + 2);
            if (c >= 1) { LAS const float* yb = (LAS const float*)(lds + SC_YB + ((c - 1) & 1) * 2048) + ytok * 16 + 2 * ypart; *(unsigned*)(yo + (size_t)(c - 1) * SC_T * RW) = pk2(yb[0], yb[1]); }
            SC_HBAR();
        }
#undef SC_HLOAD
#undef SC_HSTORE
#undef SC_HBAR
        { LAS const float* yb = (LAS const float*)(lds + SC_YB + ((NC - 1) & 1) * 2048) + ytok * 16 + 2 * ypart; *(unsigned*)(yo + (size_t)(NC - 1) * SC_T * RW) = pk2(yb[0], yb[1]); }
    } else {
        const int row = tid >> 4, ks = tid & 15;
        f32x4 s0 = (f32x4){0.f, 0.f, 0.f, 0.f};
        __syncthreads();
        for (int c = 0; c < NC; ++c) {
            LAS const float* B0 = (LAS const float*)(lds + (c & 1) * SC_BUF);
            LAS float* yb = (LAS float*)(lds + SC_YB + (c & 1) * 2048);
#define SC_LD(P, j_) { const int jl = (j_) < SC_NP ? (j_) : SC_NP - 1; LAS const float* vb = B0 + (jl * 9) * 64 + 4 * ks; \
                P##0 = *(LAS const f32x4*)(vb); P##1 = *(LAS const f32x4*)(vb + 64); P##2 = *(LAS const f32x4*)(vb + 128); P##3 = *(LAS const f32x4*)(vb + 192); P##4 = *(LAS const f32x4*)(vb + 256); \
                P##5 = *(LAS const f32x4*)(vb + 320); P##6 = *(LAS const f32x4*)(vb + 384); P##7 = *(LAS const f32x4*)(vb + 448); P##8 = *(LAS const f32x4*)(vb + 512); \
                P##c = *(LAS const f32x4*)(B0 + SC_SCAL + jl * 4); P##v = *(LAS const f32x2*)(B0 + SC_V + (jl * 16 + row) * 2); }
#define SC_STEP(P, j_) { const float d0 = red16(dot4(s0, P##0)), e1 = red16(dot4(s0, P##1)), g0 = red16(dot4(s0, P##7)); \
                const float sa0 = -d0, sa1 = (sa0 * P##c.x + P##v.x * P##c.y) - e1, y0 = g0 + (sa0 * P##c.z + P##v.x * P##c.w); \
                s0 = s0 * P##2 + (sa0 * P##3 + P##v.x * P##4) + (sa1 * P##5 + P##v.y * P##6); \
                const float y1 = red16(dot4(s0, P##8)); \
                if (ks == 0) { yb[(2 * (j_)) * 16 + row] = y0; yb[(2 * (j_) + 1) * 16 + row] = y1; } }
            f32x4 A0, A1, A2, A3, A4, A5, A6, A7, A8, Ac, B_0, B_1, B_2, B_3, B_4, B_5, B_6, B_7, B_8, B_c; f32x2 Av, B_v;
            SC_LD(A, 0); SC_LD(B_, 1);
#pragma unroll 2
            for (int j = 0; j < SC_NP; j += 2) {
                SC_STEP(A, j); SC_LD(A, j + 2);
                SC_STEP(B_, j + 1); SC_LD(B_, j + 3);
            }
#undef SC_LD
#undef SC_STEP
            __syncthreads();
        }
    }
    __syncthreads();
}
__device__ __forceinline__ void phase_scanfin(CArgs a, int l, int gw, int NGW, int lane, const bool do_store = true) {
    unsigned char* ws = a->ws;
    bf16* YA = (bf16*)(ws + WS_YA); const bf16 *VV = (const bf16*)(ws + WS_VV), *GG = (const bf16*)(ws + WS_GG); const float* BON = (const float*)(ws + WS_BONUS);
    const int ch = lane * 8;
    float lw[8], lb[8];
#pragma unroll
    for (int e = 0; e < 8; ++e) { lw[e] = a->in[19][l * 512 + ch + e]; lb[e] = a->in[20][l * 512 + ch + e]; }
#pragma unroll 2
    for (int m = gw; m < M; m += NGW) { const size_t off = (size_t)m * RW + ch; float y[8], v[8], g[8];
        unpack8(*(const v4u*)(YA + off), y); unpack8(*(const v4u*)(VV + off), v); unpack8(*(const v4u*)(GG + off), g);
        const float bs = BON[(size_t)m * 8 + (lane >> 3)];
        float s1 = 0.f;
#pragma unroll
        for (int e = 0; e < 8; ++e) s1 += y[e];
        s1 += SHX(s1, 1); s1 += SHX(s1, 2); s1 += SHX(s1, 4);
        const float mean = s1 * (1.f / 64.f); float s2 = 0.f;
#pragma unroll
        for (int e = 0; e < 8; ++e) { y[e] -= mean; s2 += y[e] * y[e]; }
        s2 += SHX(s2, 1); s2 += SHX(s2, 2); s2 += SHX(s2, 4);
        const float rstd = __builtin_amdgcn_rsqf(s2 * (1.f / 64.f) + 64e-5f);
#pragma unroll
        for (int e = 0; e < 8; ++e) y[e] = (y[e] * rstd * lw[e] + lb[e] + bs * v[e]) * g[e];
        if (do_store || y[0] == 12345.678f) *(v4u*)(YA + off) = packarr(y); }
}
constexpr int AT_BUF = 18432, AT_LDK = 72;
constexpr float AT_EXIT = 64.f;
__device__ __forceinline__ float softplus2(float z) { return fmaxf(z, 0.f) + __builtin_amdgcn_logf(1.f + __builtin_amdgcn_exp2f(-fabsf(z))); }
__device__ __forceinline__ void attn_unit(CArgs a, LAS unsigned char* lds, int l, int bh, int qb, int tid, int wave, int lane) {
    unsigned char* ws = a->ws;
    const bf16* Q = (const bf16*)(ws + WS_Q) + (size_t)bh * S * HD; const bf16* K = (const bf16*)(ws + WS_K) + (size_t)bh * S * HD; const bf16* VT = (const bf16*)(ws + WS_VT) + (size_t)bh * HD * S;
    bf16* YB = (bf16*)(ws + WS_YB);
    const int ql = lane & 31, hi = lane >> 5, qr0 = qb * 256 + wave * 32, qabs = qr0 + ql;
    bf16x8 qf[4];
    {
        const float* qg = a->in[23] + l * 64; float xq[4][8]; float ss = 0.f;
#pragma unroll
        for (int ds = 0; ds < 4; ++ds) { unpack8(*(const v4u*)(Q + (size_t)qabs * HD + 16 * ds + 8 * hi), xq[ds]);
#pragma unroll
            for (int e = 0; e < 8; ++e) ss += xq[ds][e] * xq[ds][e]; }
        const auto rr = __builtin_amdgcn_permlane32_swap(__float_as_uint(ss), __float_as_uint(ss), false, false);
        const float rstd = __builtin_amdgcn_rsqf((__uint_as_float(rr[0]) + __uint_as_float(rr[1])) * (1.f / 64.f) + 1e-6f) * (0.125f * LOG2E);
#pragma unroll
        for (int ds = 0; ds < 4; ++ds) {
#pragma unroll
            for (int e = 0; e < 8; ++e) xq[ds][e] *= rstd * qg[16 * ds + 8 * hi + e];
            qf[ds] = __builtin_bit_cast(bf16x8, packarr(xq[ds])); } }
    f32x16 o0, o1;
#pragma unroll
    for (int r = 0; r < 16; ++r) { o0[r] = 0.f; o1[r] = 0.f; }
    float L = 0.f; float wmin = 0.f;
    const int srow = tid >> 3, spart = tid & 7;
    const f32x4 kg0 = *(const f32x4*)(a->in[24] + l * 64 + spart * 8), kg1 = *(const f32x4*)(a->in[24] + l * 64 + spart * 8 + 4);
#define AT_KNORM(kq_) { float xk[8]; unpack8(kq_, xk); float ss = 0.f; _Pragma("unroll") for (int e = 0; e < 8; ++e) ss += xk[e] * xk[e]; \
        ss += SHX(ss, 1); ss += SHX(ss, 2); ss += SHX(ss, 4); const float rs_ = __builtin_amdgcn_rsqf(ss * (1.f / 64.f) + 1e-6f); \
        _Pragma("unroll") for (int e = 0; e < 4; ++e) { xk[e] *= rs_ * kg0[e]; xk[e + 4] *= rs_ * kg1[e]; } kq_ = packarr(xk); }
    LAS float* lmin = (LAS float*)(lds + MISC_OFF + 64);
    int kt = qb * 4 + 3;
    v4u kq = *(const v4u*)(K + (size_t)(64 * kt + srow) * HD + spart * 8), vq = *(const v4u*)(VT + (size_t)srow * S + 64 * kt + spart * 8);
    AT_KNORM(kq);
    *(LAS v4u*)(lds + srow * (AT_LDK * 2) + spart * 16) = kq; *(LAS v4u*)(lds + 9216 + srow * (AT_LDK * 2) + spart * 16) = vq;
    __syncthreads();
    int cur = 0;
    for (; kt >= 0; --kt) {
        if (kt > 0) { kq = *(const v4u*)(K + (size_t)(64 * (kt - 1) + srow) * HD + spart * 8); vq = *(const v4u*)(VT + (size_t)srow * S + 64 * (kt - 1) + spart * 8); }
        LAS const unsigned char* Ks = lds + cur * AT_BUF; LAS const unsigned char* Vs = Ks + 9216;
        if (64 * kt < qr0 + 31 && wmin <= AT_EXIT) {
            f32x16 p0, p1;
#pragma unroll
            for (int r = 0; r < 16; ++r) { p0[r] = 0.f; p1[r] = 0.f; }
#pragma unroll
            for (int ds = 0; ds < 4; ++ds) { const bf16x8 k0 = *(LAS const bf16x8*)(Ks + ql * (AT_LDK * 2) + ds * 32 + hi * 16), k1 = *(LAS const bf16x8*)(Ks + (32 + ql) * (AT_LDK * 2) + ds * 32 + hi * 16);
                p0 = __builtin_amdgcn_mfma_f32_32x32x16_f16(__builtin_bit_cast(h16x8, k0), __builtin_bit_cast(h16x8, qf[ds]), p0, 0, 0, 0); p1 = __builtin_amdgcn_mfma_f32_32x32x16_f16(__builtin_bit_cast(h16x8, k1), __builtin_bit_cast(h16x8, qf[ds]), p1, 0, 0, 0); }
            const bool need_mask = (64 * kt + 63 >= qr0);
            f32x16 sp0, sp1;
#pragma unroll
            for (int r = 0; r < 16; ++r) { const int kl = (r & 3) + 8 * (r >> 2) + 4 * hi; float a0 = softplus2(p0[r]), a1 = softplus2(p1[r]);
                p0[r] -= a0; p1[r] -= a1;
                if (need_mask) { if (64 * kt + kl >= qabs) { a0 = 0.f; p0[r] = -1e30f; } if (64 * kt + 32 + kl >= qabs) { a1 = 0.f; p1[r] = -1e30f; } }
                sp0[r] = a0; sp1[r] = a1; }
            float off[8]; float run = 0.f;
#pragma unroll
            for (int g = 7; g >= 0; --g) { const float gs = g < 4 ? (sp0[4 * g] + sp0[4 * g + 1]) + (sp0[4 * g + 2] + sp0[4 * g + 3]) : (sp1[4 * g - 16] + sp1[4 * g - 15]) + (sp1[4 * g - 14] + sp1[4 * g - 13]);
                const auto rr = __builtin_amdgcn_permlane32_swap(__float_as_uint(gs), __float_as_uint(gs), false, false);
                const float x0 = __uint_as_float(rr[0]), x1 = __uint_as_float(rr[1]);
                off[g] = run + (hi ? 0.f : x1);
                run += x0 + x1; }
            bf16x8 pf[4];
#pragma unroll
            for (int g = 0; g < 8; ++g) { float e3, e2, e1, e0;
                if (g < 4) { e3 = off[g] + L; e2 = e3 + sp0[4 * g + 3]; e1 = e2 + sp0[4 * g + 2]; e0 = e1 + sp0[4 * g + 1];
                    const float w0 = __builtin_amdgcn_exp2f(p0[4 * g] - e0), w1 = __builtin_amdgcn_exp2f(p0[4 * g + 1] - e1), w2 = __builtin_amdgcn_exp2f(p0[4 * g + 2] - e2), w3 = __builtin_amdgcn_exp2f(p0[4 * g + 3] - e3);
                    const unsigned u0 = pk2(w0, w1), u1 = pk2(w2, w3); const int j = g >> 1, e = (g & 1) * 4;
                    pf[j][e] = (short)(u0 & 0xffff); pf[j][e + 1] = (short)(u0 >> 16); pf[j][e + 2] = (short)(u1 & 0xffff); pf[j][e + 3] = (short)(u1 >> 16); }
                else { const int gg = g - 4; e3 = off[g] + L; e2 = e3 + sp1[4 * gg + 3]; e1 = e2 + sp1[4 * gg + 2]; e0 = e1 + sp1[4 * gg + 1];
                    const float w0 = __builtin_amdgcn_exp2f(p1[4 * gg] - e0), w1 = __builtin_amdgcn_exp2f(p1[4 * gg + 1] - e1), w2 = __builtin_amdgcn_exp2f(p1[4 * gg + 2] - e2), w3 = __builtin_amdgcn_exp2f(p1[4 * gg + 3] - e3);
                    const unsigned u0 = pk2(w0, w1), u1 = pk2(w2, w3); const int j = g >> 1, e = (g & 1) * 4;
                    pf[j][e] = (short)(u0 & 0xffff); pf[j][e + 1] = (short)(u0 >> 16); pf[j][e + 2] = (short)(u1 & 0xffff); pf[j][e + 3] = (short)(u1 >> 16); } }
            L += run;
#pragma unroll
            for (int j = 0; j < 4; ++j) {
                const v2u a00 = *(LAS const v2u*)(Vs + ql * (AT_LDK * 2) + (16 * j + 4 * hi) * 2), a01 = *(LAS const v2u*)(Vs + ql * (AT_LDK * 2) + (16 * j + 8 + 4 * hi) * 2);
                const v2u a10 = *(LAS const v2u*)(Vs + (32 + ql) * (AT_LDK * 2) + (16 * j + 4 * hi) * 2), a11 = *(LAS const v2u*)(Vs + (32 + ql) * (AT_LDK * 2) + (16 * j + 8 + 4 * hi) * 2);
                const v4u A0 = (v4u){a00.x, a00.y, a01.x, a01.y}, A1 = (v4u){a10.x, a10.y, a11.x, a11.y};
                o0 = __builtin_amdgcn_mfma_f32_32x32x16_f16(__builtin_bit_cast(h16x8, A0), __builtin_bit_cast(h16x8, pf[j]), o0, 0, 0, 0);
                o1 = __builtin_amdgcn_mfma_f32_32x32x16_f16(__builtin_bit_cast(h16x8, A1), __builtin_bit_cast(h16x8, pf[j]), o1, 0, 0, 0); }
        }
        float wm = L;
#pragma unroll
        for (int o = 1; o < 64; o <<= 1) wm = fminf(wm, SHX(wm, o));
        wmin = wm;
        if (lane == 0) lmin[wave] = wm;
        __syncthreads();
        float bm = lmin[0];
#pragma unroll
        for (int w = 1; w < 8; ++w) bm = fminf(bm, lmin[w]);
        if (bm > AT_EXIT || kt == 0) break;
        cur ^= 1;
        AT_KNORM(kq);
        *(LAS v4u*)(lds + cur * AT_BUF + srow * (AT_LDK * 2) + spart * 16) = kq; *(LAS v4u*)(lds + cur * AT_BUF + 9216 + srow * (AT_LDK * 2) + spart * 16) = vq;
        __syncthreads();
    }
    const int b = bh >> 3, h = bh & 7;
    bf16* yrow = YB + ((size_t)b * S + qabs) * RW + h * 64;
#pragma unroll
    for (int g = 0; g < 4; ++g) { v2u w; w.x = pk2(o0[4 * g], o0[4 * g + 1]); w.y = pk2(o0[4 * g + 2], o0[4 * g + 3]); *(v2u*)(yrow + 8 * g + 4 * hi) = w;
        w.x = pk2(o1[4 * g], o1[4 * g + 1]); w.y = pk2(o1[4 * g + 2], o1[4 * g + 3]); *(v2u*)(yrow + 32 + 8 * g + 4 * hi) = w; }
    __syncthreads();
}
__device__ __forceinline__ void phase_mixer(CArgs a, LAS unsigned char* lds, int l, const int wave_s) {
    unsigned* ctr = (unsigned*)(a->ws + WS_CTL) + 64 * l; l &= 3;
    volatile LAS unsigned* qw = (volatile LAS unsigned*)(lds + MISC_OFF);
#ifdef PROBE_ATT2
    constexpr int NU = 256 + 2 * 64 * 16;
#else
    constexpr int NU = 256 + 64 * 16;
#endif
    for (;;) {
        const int lane = fresh_lane(), wave = wave_s, tid = wave * 64 + lane;
        if (tid == 0) qw[0] = atomicAdd(ctr, 1u);
        __syncthreads();
        const int u = (int)qw[0];
        __syncthreads();
        if (u >= NU) break;
        if (u < 256) scan_unit(a, lds, l, u >> 2, u & 3, tid);
        else { const int v = (u - 256) & 1023; attn_unit(a, lds, l, v & 63, 15 - (v >> 6), tid, wave, lane); }
    }
}
#define XB_TMO      128
#define XB_XCNT(j)  (256  + 64 * (j))
#define XB_XSUB(j)  (1280 + 64 * (j))
#define XB_XGEN(j)  (2304 + 64 * (j))
#define XB_TOP      3328
#define XB_TOPGEN   3392
#define XCD_BAR_WORDS 3456
#define XB_SPIN_CAP (1u << 18)
constexpr int BAR_WORD0 = 16384;
__device__ __forceinline__ unsigned xb_ld(unsigned* p)              { return __hip_atomic_load(p, __ATOMIC_RELAXED, __HIP_MEMORY_SCOPE_AGENT); }
__device__ __forceinline__ unsigned xb_add(unsigned* p, unsigned v) { return __hip_atomic_fetch_add(p, v, __ATOMIC_RELAXED, __HIP_MEMORY_SCOPE_AGENT); }
__device__ __forceinline__ unsigned xb_xcc_id() { return (unsigned)__builtin_amdgcn_s_getreg((3 << 11) | 20) & 0xFu; }
#define XB_SPIN(cond, bar) do { unsigned _sp = 0; while (cond) { __builtin_amdgcn_s_sleep(1); \
    if ((++_sp & 255u) == 0u) { if (xb_ld(&(bar)[XB_TMO])) break; if (_sp > XB_SPIN_CAP) { atomicAdd(&(bar)[XB_TMO], 1u); break; } } } } while (0)
__device__ __forceinline__ void xcd_barrier_complete(unsigned* bar, unsigned x, unsigned& nloc, unsigned& nx) {
    const unsigned G = gridDim.x * gridDim.y * gridDim.z;
    unsigned sum, cnt, mine, sp = 0u;
    for (;;) {
        sum = 0u; cnt = 0u; mine = 0u;
#pragma unroll
        for (unsigned j = 0; j < 16; ++j) { const unsigned c = xb_ld(&bar[XB_XCNT(j)]); sum += c; cnt += (c > 0u) ? 1u : 0u; mine = (j == x) ? c : mine; }
        if (sum == G) break;
        __builtin_amdgcn_s_sleep(1);
        if ((++sp & 255u) == 0u) { if (xb_ld(&bar[XB_TMO])) break; if (sp > XB_SPIN_CAP) { atomicAdd(&bar[XB_TMO], 1u); break; } }
    }
    nloc = mine > 0u ? mine : 1u; nx = cnt > 0u ? cnt : 1u;
}
__device__ __forceinline__ void grid_barrier(unsigned* ctl, LAS unsigned char* lds, const int wave_s) {
    asm volatile("s_waitcnt vmcnt(0) lgkmcnt(0)" ::: "memory");
    __syncthreads();
    if (wave_s * 64 + fresh_lane() == 0) {
        unsigned* bar = ctl + BAR_WORD0; volatile LAS unsigned* st = (volatile LAS unsigned*)(lds + MISC_OFF + 128);
        const unsigned x = xb_xcc_id();
        __builtin_amdgcn_s_waitcnt(0);
        unsigned nloc = st[0], nx = st[1];
        if (nloc == 0u) { xcd_barrier_complete(bar, x, nloc, nx); st[0] = nloc; st[1] = nx; }
        const unsigned old = xb_add(&bar[XB_XSUB(x)], 1u);
        const unsigned gen = old / nloc;
        if (old + 1u == (gen + 1u) * nloc) {
            __builtin_amdgcn_fence(__ATOMIC_RELEASE, "agent");
            asm volatile("s_waitcnt vmcnt(0)" ::: "memory");
            const unsigned og = xb_add(&bar[XB_TOP], 1u);
            const unsigned tg = og / nx;
            if (og + 1u == (tg + 1u) * nx) xb_add(&bar[XB_TOPGEN], 1u);
            else XB_SPIN(xb_ld(&bar[XB_TOPGEN]) == tg, bar);
            __builtin_amdgcn_fence(__ATOMIC_ACQUIRE, "agent");
            xb_add(&bar[XB_XGEN(x)], 1u);
            asm volatile("s_waitcnt vmcnt(0)" ::: "memory");
        } else {
            XB_SPIN(xb_ld(&bar[XB_XGEN(x)]) == gen, bar);
            __builtin_amdgcn_fence(__ATOMIC_ACQUIRE, "agent");
            asm volatile("s_waitcnt vmcnt(0)" ::: "memory");
        }
    }
    __syncthreads();
}
__global__ void __launch_bounds__(512, 2) mk_fwd(Args a) {
    extern __shared__ __attribute__((aligned(16))) unsigned char lds_raw[];
    LAS unsigned char* lds = (LAS unsigned char*)lds_raw;
    cg::grid_group grid = cg::this_grid();
    const int wave_k = __builtin_amdgcn_readfirstlane((int)threadIdx.x >> 6);
    { const int t0 = wave_k * 64 + fresh_lane(); if (t0 < 2) ((volatile LAS unsigned*)(lds + MISC_OFF + 128))[t0] = 0u;
      if (t0 == 0) (void)xb_add((unsigned*)(a.ws + WS_CTL) + BAR_WORD0 + XB_XCNT(xb_xcc_id()), 1u); }
    __syncthreads();
    grid.sync();
    unsigned bar_round = 0;
    const int ph_lo = a.ph_lo, ph_hi = a.ph_hi;
    for (int ph = ph_lo; ph < ph_hi; ++ph) {
        int bid = blockIdx.x; asm volatile("" : "+s"(bid));
        int wave_s = wave_k; asm volatile("" : "+s"(wave_s));
#define FRESH_TID() const int lane = fresh_lane(), wave = wave_s, tid = wave * 64 + lane, gw = bid * 8 + wave; (void)tid; (void)gw
        CArgs ap = (CArgs)__builtin_amdgcn_kernarg_segment_ptr(); asm volatile("" : "+s"(ap));
        const int G = gridDim.x, NGW = G * 8;
        unsigned char* ws = ap->ws;
        const float* mod = (const float*)(ws + WS_MOD);
        if (ph == 0) {
#ifndef SK_MOD
            FRESH_TID(); phase_mod(ap, lds, tid, bid, G);
#ifdef PROBE_THIN2
            __syncthreads(); phase_mod(ap, lds, tid, bid, G);
#endif
#endif
        }
        else {
            const int l = (ph - 1) / NPH_LAYER, idx = (ph - 1) % NPH_LAYER;
            const float* modl = mod + (size_t)l * 8 * 9216;
            if (0) {}
#ifndef SK_NORM
            else if (idx == 0 || idx == 3 || idx == 11) {
                FRESH_TID();
                if (idx == 0) phase_convert(ap, lds, l, gw, NGW, wave, lane, bid * 512 + tid, G * 512);
#ifdef PROBE_CONV2
                if (idx == 0) { __syncthreads(); phase_convert(ap, lds, l, gw, NGW, wave, lane, bid * 512 + tid, G * 512); }
#endif
                const int i3 = idx == 0 ? 0 : (idx == 3 ? 1 : 2);
                phase_norm((l == 0 && idx == 0) ? ap->in[0] : nullptr, (const bf16*)(ws + WS_H16), ap->in[4] + (size_t)(l * 3 + i3) * 1024, modl, i3, (bf16*)(ws + WS_N), gw, NGW, lane);
#ifdef PROBE_NORM2
                phase_norm((l == 0 && idx == 0) ? ap->in[0] : nullptr, (const bf16*)(ws + WS_H16), ap->in[4] + (size_t)(l * 3 + i3) * 1024, modl, i3, (bf16*)(ws + WS_N), gw, NGW, lane);
#endif
            }
#endif
#ifndef SK_G1
            else if (idx == 1 || idx == 12) {
                pg8::Gemm g{(const pg8::bf16_t*)(ws + WS_N), (const pg8::bf16_t*)(ws + (idx == 1 ? WS_WG1 : WS_WG1B)), M, 2 * FF, D}; pg8::StaticOrder So; So.init(M, 2 * FF, G, bid);
                EpiSwiglu E{(bf16*)(ws + WS_ACT)};
                pg8::gemm_phase<EpiSwiglu, pg8::StaticOrder, true, true>(lds, g, So, E, wave_s);
#ifdef PROBE_G1X2
                __syncthreads(); pg8::gemm_phase<EpiSwiglu, pg8::StaticOrder, true, true>(lds, g, So, E, wave_s);
#endif
#ifdef PROBE_G1X2B
                ++bar_round; grid_barrier((unsigned*)(ap->ws + WS_CTL), lds, wave_s);
                pg8::gemm_phase<EpiSwiglu, pg8::StaticOrder, true, true>(lds, g, So, E, wave_s);
#endif
            }
#endif
#ifndef SK_G2
            else if (idx == 2 || idx == 10 || idx == 13) {
                const bf16* A = (const bf16*)(ws + (idx == 10 ? WS_MERGED : WS_ACT)); const bf16* Bt = (const bf16*)(ws + (idx == 2 ? WS_WG2 : (idx == 10 ? WS_WOUT : WS_WG2B)));
                pg8::Gemm g{A, Bt, M, D, idx == 10 ? D : FF}; pg8::StaticOrder So; So.init(M, D, G, bid);
                EpiResid E{ap, l, idx};
#ifdef PROBE_G2NULL
                { EpiNull En{(float*)(ws + WS_CTL) + 900}; pg8::gemm_phase<EpiNull, pg8::StaticOrder, true, true>(lds, g, So, En, wave_s); __syncthreads(); }
#endif
                pg8::gemm_phase<EpiResid, pg8::StaticOrder, true, true>(lds, g, So, E, wave_s);
            }
#endif
#ifndef SK_IN
            else if (idx == 4) {
                const int nn = l == 0 ? 5376 : 5632;
                pg8::Gemm g{(const bf16*)(ws + WS_N), (const bf16*)(ws + WS_WIN), M, nn, D}; pg8::StaticOrder So; So.init(M, nn, G, bid);
                EpiIn E{ws, ap->out};
                pg8::gemm_phase<EpiIn, pg8::StaticOrder, true, true>(lds, g, So, E, wave_s);
#ifdef PROBE_IN2
                __syncthreads(); pg8::gemm_phase<EpiIn, pg8::StaticOrder, true, true>(lds, g, So, E, wave_s);
#endif
#ifdef PROBE_ALLB
                ++bar_round; grid_barrier((unsigned*)(ap->ws + WS_CTL), lds, wave_s); pg8::gemm_phase<EpiIn, pg8::StaticOrder, true, true>(lds, g, So, E, wave_s);
#endif
            }
#endif
#ifndef SK_PREP
            else if (idx == 5) {
                FRESH_TID(); phase_prep(ap, l, gw, NGW, lane);
#ifdef PROBE_THIN2
                phase_prep(ap, l, gw, NGW, lane, false);
#endif
            }
#endif
#ifndef SK_LORA
            else if (idx == 6) {
                pg8::Gemm g{(const bf16*)(ws + WS_ALORA), (const bf16*)(ws + WS_WLORA), M, 2048, 384};
                OffOrder So; So.b.init(M, 512, G, bid);
                So.off = 0; { EpiLora<0> E{ap, l}; pg8::gemm_phase<EpiLora<0>, OffOrder, true, true>(lds, g, So, E, wave_s); } __syncthreads();
#ifdef PROBE_LORA2
                So.off = 0; { EpiLora<0> E{ap, l}; pg8::gemm_phase<EpiLora<0>, OffOrder, true, true>(lds, g, So, E, wave_s); } __syncthreads();
                So.off = 4; { EpiLora<2> E{ap, l}; pg8::gemm_phase<EpiLora<2>, OffOrder, true, true>(lds, g, So, E, wave_s); } __syncthreads();
#endif
                So.off = 2; { EpiLora<1> E{ap, l}; pg8::gemm_phase<EpiLora<1>, OffOrder, true, true>(lds, g, So, E, wave_s); } __syncthreads();
                So.off = 4; { EpiLora<2> E{ap, l}; pg8::gemm_phase<EpiLora<2>, OffOrder, true, true>(lds, g, So, E, wave_s); } __syncthreads();
                if (l > 0) { So.off = 6; EpiLora<3> E{ap, l}; pg8::gemm_phase<EpiLora<3>, OffOrder, true, true>(lds, g, So, E, wave_s); }
            }
#endif
#ifndef SK_MIX
            else if (idx == 7) {
                phase_mixer(ap, lds, l, wave_s);
#ifdef PROBE_MIX2
                ++bar_round; grid_barrier((unsigned*)(ap->ws + WS_CTL), lds, wave_s); phase_mixer(ap, lds, l + 4, wave_s);
#endif
            }
#endif
#ifndef SK_UP
            else if (idx == 8) { FRESH_TID();
#ifdef PROBE_THIN2
                phase_scanfin(ap, l, gw, NGW, lane, false);
#endif
                phase_scanfin(ap, l, gw, NGW, lane); }
            else if (idx == 9) {
#if defined(PROBE_UP2) || defined(PROBE_ALLB)
              for (int rep = 0; rep < 2; ++rep) {
#endif
                { pg8::Gemm g{(const bf16*)(ws + WS_YA), (const bf16*)(ws + WS_WUPA), M, D, RW}; pg8::StaticOrder So; So.init(M, D, G, bid);
                  EpiUp<0> E{ws, ap->out};
                  pg8::gemm_phase<EpiUp<0>, pg8::StaticOrder, true, true>(lds, g, So, E, wave_s); }
                __syncthreads();
                { pg8::Gemm g{(const bf16*)(ws + WS_YB), (const bf16*)(ws + WS_WUPB), M, D, RW}; pg8::StaticOrder So; So.init(M, D, G, bid);
                  EpiUp<1> E{ws, ap->out};
                  pg8::gemm_phase<EpiUp<1>, pg8::StaticOrder, true, true>(lds, g, So, E, wave_s); }
#ifdef PROBE_UP2
                __syncthreads(); }
#endif
#ifdef PROBE_ALLB
                if (rep == 0) { ++bar_round; grid_barrier((unsigned*)(ap->ws + WS_CTL), lds, wave_s); } }
#endif
            }
#endif
        }
        if (ph + 1 < ph_hi) { ++bar_round; grid_barrier((unsigned*)(ap->ws + WS_CTL), lds, wave_s); }
#ifdef PROBE_BAR2
        if (ph + 1 < ph_hi) { ++bar_round; grid_barrier((unsigned*)(ap->ws + WS_CTL), lds, wave_s); }
#endif
    }
}

extern "C" void kernel_launch(void* const* d_in, const int* in_sizes, int n_in, void* d_out, int out_size, void* d_ws, size_t ws_size, hipStream_t stream) {
    static int grid = 0;
    if (grid == 0) {
        if (n_in != 31 || out_size != M * D || ws_size < WS_END) { fprintf(stderr, "kernel_launch: unexpected shapes (n_in %d, out %d, ws %zu < %zu)\n", n_in, out_size, ws_size, (size_t)WS_END); grid = -1; return; }
        int dev = 0, cus = 0, per_cu = 0;
        hipGetDevice(&dev); hipDeviceGetAttribute(&cus, hipDeviceAttributeMultiprocessorCount, dev);
        hipFuncSetAttribute((const void*)mk_fwd, hipFuncAttributeMaxDynamicSharedMemorySize, LDS_BYTES);
        hipOccupancyMaxActiveBlocksPerMultiprocessor(&per_cu, (const void*)mk_fwd, 512, LDS_BYTES);
        (void)hipGetLastError();
        if (per_cu < 1) per_cu = 1;
        grid = cus * per_cu;
    }
    if (grid < 0) return;
    hipMemsetAsync((char*)d_ws + WS_CTL, 0, 131072, stream);
    Args a{};
    for (int i = 0; i < 31; ++i) a.in[i] = (const float*)d_in[i];
    a.out = (float*)d_out; a.ws = (unsigned char*)d_ws; a.ph_lo = 0; a.ph_hi = NPHASES;
    void* args[] = {&a};
    hipError_t e = hipLaunchCooperativeKernel((const void*)mk_fwd, dim3(grid), dim3(512), args, LDS_BYTES, stream);
    if (e != hipSuccess) fprintf(stderr, "cooperative launch failed: %s (grid %d)\n", hipGetErrorString(e), grid);
}
```
